# Optimizing an MI355X kernel written in HIP

```python
import math
import jax, jax.numpy as jnp
from jax import lax
import numpy as np


D_MODEL = 2048
BATCH = 4
SEQ = 2048
DEPTH = 1
DEC_BATCH = 16
DEC_SEQ = 2048
PAST_LEN = 128

HEAD_DIM = 128
N_HEADS_A = 6
N_KV_A = 2
GQA_GROUP = N_HEADS_A // N_KV_A
DIL_PAIRS = ((128, 1), (512, 4), (2048, 16))
N_DIL = len(DIL_PAIRS)
HEADS_PER_DIL = 2
N_HEADS_B = N_DIL * HEADS_PER_DIL
N_HEADS_M = 4
N_MEM = 256
WIDTH_A = N_HEADS_A * HEAD_DIM
WIDTH_B = N_HEADS_B * HEAD_DIM
WIDTH_M = N_HEADS_M * HEAD_DIM
MIX_WIDTH = WIDTH_A + WIDTH_B + WIDTH_M
IN_SIZES = (WIDTH_A, N_KV_A * HEAD_DIM, N_KV_A * HEAD_DIM, WIDTH_B, WIDTH_B, WIDTH_B, WIDTH_M)
IN_COLS = sum(IN_SIZES)
IN_SPLITS = tuple(int(c) for c in np.cumsum(IN_SIZES)[:-1])
D_FF = 4 * D_MODEL
GRID_W = 64
ROPE_THETA = 10000.0
ROPE_AXIS_DIM = HEAD_DIM // 2
ROPE_PAIRS = ROPE_AXIS_DIM // 2
NUM_BUCKETS = 32
MAX_DISTANCE = 1024
Q_BLOCK = 128
EPS = 1e-6
NEG_INF = -1e30
ATTN_SCALE = HEAD_DIM ** -0.5

kernel_name = "hymba_parallel_dilated_encoder"


def rms_norm(x, g):
    xf = x.astype(jnp.float32)
    y = xf * lax.rsqrt(jnp.mean(jnp.square(xf), axis=-1, keepdims=True) + EPS)
    return (y * g.astype(jnp.float32)).astype(x.dtype)


def t5_bucket(rel):
    nb = NUM_BUCKETS // 2
    max_exact = nb // 2
    base = jnp.where(rel > 0, nb, 0)
    n = jnp.abs(rel)
    nf = jnp.maximum(n, 1).astype(jnp.float32)
    large = max_exact + (jnp.log(nf / max_exact) / math.log(MAX_DISTANCE / max_exact)
                         * (nb - max_exact)).astype(jnp.int32)
    large = jnp.minimum(large, nb - 1)
    return base + jnp.where(n < max_exact, n, large)


def axial_rope_tables(seq_len):
    rows = seq_len // GRID_W
    row = jnp.repeat(jnp.arange(rows), GRID_W).astype(jnp.float32)
    col = jnp.tile(jnp.arange(GRID_W), rows).astype(jnp.float32)
    inv = ROPE_THETA ** (-(2.0 * jnp.arange(ROPE_PAIRS, dtype=jnp.float32)) / ROPE_AXIS_DIM)
    ang_r = (row[:, None] * inv)[:, None, :]
    ang_c = (col[:, None] * inv)[:, None, :]
    return jnp.cos(ang_r), jnp.sin(ang_r), jnp.cos(ang_c), jnp.sin(ang_c)


def _rotate(a, cos, sin):
    a1, a2 = a[..., :ROPE_PAIRS], a[..., ROPE_PAIRS:]
    return jnp.concatenate([a1 * cos - a2 * sin, a2 * cos + a1 * sin], axis=-1)


def apply_axial_rope(x, cos_r, sin_r, cos_c, sin_c):
    xf = x.astype(jnp.float32)
    xr = _rotate(xf[..., :ROPE_AXIS_DIM], cos_r, sin_r)
    xc = _rotate(xf[..., ROPE_AXIS_DIM:], cos_c, sin_c)
    return jnp.concatenate([xr, xc], axis=-1).astype(x.dtype)


def gqa_attention(q, k, v):
    B, S = q.shape[0], q.shape[1]
    nblk = S // Q_BLOCK
    qg = q.reshape(B, nblk, Q_BLOCK, N_KV_A, GQA_GROUP, HEAD_DIM).transpose(1, 0, 2, 3, 4, 5)

    def block(qi):
        s = jnp.einsum("bqkgd,bskd->bkgqs", qi, k).astype(jnp.float32) * ATTN_SCALE
        p = jax.nn.softmax(s, axis=-1).astype(v.dtype)
        return jnp.einsum("bkgqs,bskd->bqkgd", p, v)

    o = lax.map(block, qg)
    return o.transpose(1, 0, 2, 3, 4, 5).reshape(B, S, WIDTH_A)


def dilated_group(q, k, v, bias_tab, window, dil):
    B, S, H, Dh = q.shape
    n_side = window // (2 * dil)
    band = n_side
    L = S // dil
    Lp = -(-L // band) * band
    nb = Lp // band

    def to_sub(x):
        x = x.reshape(B, L, dil, H, Dh).transpose(0, 2, 1, 3, 4)
        return jnp.pad(x, ((0, 0), (0, 0), (0, Lp - L), (0, 0), (0, 0)))

    def to_band(x):
        xp = jnp.pad(x, ((0, 0), (0, 0), (band, band), (0, 0), (0, 0)))
        xp = xp.reshape(B, dil, nb + 2, band, H, Dh)
        return jnp.concatenate([xp[:, :, :-2], xp[:, :, 1:-1], xp[:, :, 2:]], axis=3)

    qs = to_sub(q).reshape(B, dil, nb, band, H, Dh)
    kb = to_band(to_sub(k))
    vb = to_band(to_sub(v))

    i = jnp.arange(band)
    j = jnp.arange(3 * band)
    rel = j[None, :] - band - i[:, None]
    key_m = jnp.arange(nb)[:, None, None] * band - band + j[None, None, :]
    valid = (jnp.abs(rel) <= n_side)[None] & (key_m >= 0) & (key_m < L)
    bias = bias_tab[t5_bucket(rel * dil)].astype(jnp.float32).transpose(2, 0, 1)

    s = jnp.einsum("bcnqhd,bcnkhd->bcnhqk", qs, kb).astype(jnp.float32) * ATTN_SCALE
    s = jnp.where(valid[None, None, :, None], s + bias[None, None, None], NEG_INF)
    lse = jax.nn.logsumexp(s, axis=-1)
    p = jnp.exp(s - lse[..., None]).astype(v.dtype)
    o = jnp.einsum("bcnhqk,bcnkhd->bcnqhd", p, vb)
    o = o.reshape(B, dil, Lp, H, Dh)[:, :, :L].transpose(0, 2, 1, 3, 4).reshape(B, S, H, Dh)
    lse = lse.transpose(0, 1, 2, 4, 3).reshape(B, dil, Lp, H)[:, :, :L]
    lse = lse.transpose(0, 2, 1, 3).reshape(B, S, H)
    return o, lse


def dilated_attention(q, k, v, rel_bias):
    B, S = q.shape[0], q.shape[1]
    shp = (B, S, N_DIL, HEADS_PER_DIL, HEAD_DIM)
    q, k, v = q.reshape(shp), k.reshape(shp), v.reshape(shp)
    tab = rel_bias.reshape(NUM_BUCKETS, N_DIL, HEADS_PER_DIL)
    outs, lses = [], []
    for g, (window, dil) in enumerate(DIL_PAIRS):
        o, lse = dilated_group(q[:, :, g], k[:, :, g], v[:, :, g], tab[:, g], window, dil)
        outs.append(o)
        lses.append(lse)
    alpha = jax.nn.softmax(jnp.stack(lses), axis=0)
    o = alpha[..., None] * jnp.stack(outs).astype(jnp.float32)
    return o.transpose(1, 2, 0, 3, 4).reshape(B, S, WIDTH_B).astype(q.dtype)


def memory_attention(q, mem, mem_norm, w_mem_kv):
    B, S = q.shape[0], q.shape[1]
    q = q.reshape(B, S, N_HEADS_M, HEAD_DIM)
    kv = (rms_norm(mem, mem_norm) @ w_mem_kv).reshape(B, mem.shape[1], 2, N_HEADS_M, HEAD_DIM)
    s = jnp.einsum("bshd,bmhd->bhsm", q, kv[:, :, 0]).astype(jnp.float32) * ATTN_SCALE
    p = jax.nn.softmax(s, axis=-1).astype(q.dtype)
    return jnp.einsum("bhsm,bmhd->bshd", p, kv[:, :, 1]).reshape(B, S, WIDTH_M)


def encoder_layer(x, mem, rel_bias, pre_mix_norm, w_in, q_norm_a, k_norm_a, mem_norm,
                  w_mem_kv, out_norm_a, out_norm_b, out_norm_m, w_out, post_mix_norm,
                  pre_ffn_norm, w_up, w_down, post_ffn_norm):
    B, S, _ = x.shape
    h = rms_norm(x, pre_mix_norm)
    qa, ka, va, qb, kb, vb, qm = jnp.split(h @ w_in, IN_SPLITS, axis=-1)

    cos_r, sin_r, cos_c, sin_c = axial_rope_tables(S)
    qa = apply_axial_rope(rms_norm(qa.reshape(B, S, N_HEADS_A, HEAD_DIM), q_norm_a), cos_r, sin_r, cos_c, sin_c)
    ka = apply_axial_rope(rms_norm(ka.reshape(B, S, N_KV_A, HEAD_DIM), k_norm_a), cos_r, sin_r, cos_c, sin_c)
    o_a = gqa_attention(qa, ka, va.reshape(B, S, N_KV_A, HEAD_DIM))

    o_b = dilated_attention(qb, kb, vb, rel_bias)

    o_m = memory_attention(qm, mem, mem_norm, w_mem_kv)

    mix = jnp.concatenate([rms_norm(o_a, out_norm_a), rms_norm(o_b, out_norm_b),
                           rms_norm(o_m, out_norm_m)], axis=-1)
    x = x + rms_norm(mix @ w_out, post_mix_norm)

    h = rms_norm(x, pre_ffn_norm)
    u = jnp.square(jax.nn.relu(h @ w_up))
    return x + rms_norm(u @ w_down, post_ffn_norm)


def setup_inputs(seed: int = 0) -> dict:
    key = jax.random.key(seed)
    ks = jax.random.split(key, 24)

    def nrm(k, shape, scale):
        return jax.random.normal(k, shape, jnp.float32) * scale

    def gain(k, shape):
        return 1.0 + 0.02 * jax.random.normal(k, shape, jnp.float32)

    return {
        "x_prompt": nrm(ks[0], (BATCH, SEQ, D_MODEL), 1.0),
        "x_sample": nrm(ks[1], (DEC_BATCH, DEC_SEQ, D_MODEL), 1.0),
        "mem_prompt": nrm(ks[2], (BATCH, N_MEM, D_MODEL), 1.0),
        "mem_sample": nrm(ks[3], (DEC_BATCH, N_MEM, D_MODEL), 1.0),
        "rel_bias": nrm(ks[4], (NUM_BUCKETS, N_HEADS_B), 0.5),
        "pre_mix_norm": gain(ks[5], (DEPTH, D_MODEL)),
        "w_in": nrm(ks[6], (DEPTH, D_MODEL, IN_COLS), D_MODEL ** -0.5),
        "q_norm_a": gain(ks[7], (DEPTH, HEAD_DIM)),
        "k_norm_a": gain(ks[8], (DEPTH, HEAD_DIM)),
        "mem_norm": gain(ks[9], (DEPTH, D_MODEL)),
        "w_mem_kv": nrm(ks[10], (DEPTH, D_MODEL, 2 * WIDTH_M), D_MODEL ** -0.5),
        "out_norm_a": gain(ks[11], (DEPTH, WIDTH_A)),
        "out_norm_b": gain(ks[12], (DEPTH, WIDTH_B)),
        "out_norm_m": gain(ks[13], (DEPTH, WIDTH_M)),
        "w_out": nrm(ks[14], (DEPTH, MIX_WIDTH, D_MODEL), MIX_WIDTH ** -0.5),
        "post_mix_norm": gain(ks[15], (DEPTH, D_MODEL)),
        "pre_ffn_norm": gain(ks[16], (DEPTH, D_MODEL)),
        "w_up": nrm(ks[17], (DEPTH, D_MODEL, D_FF), D_MODEL ** -0.5),
        "w_down": nrm(ks[18], (DEPTH, D_FF, D_MODEL), D_FF ** -0.5),
        "post_ffn_norm": gain(ks[19], (DEPTH, D_MODEL)),
    }


def reference(x_prompt, x_sample, mem_prompt, mem_sample, rel_bias, pre_mix_norm, w_in,
              q_norm_a, k_norm_a, mem_norm, w_mem_kv, out_norm_a, out_norm_b, out_norm_m,
              w_out, post_mix_norm, pre_ffn_norm, w_up, w_down, post_ffn_norm):
    def trunk(x, mem):
        for l in range(DEPTH):
            x = encoder_layer(x, mem, rel_bias, pre_mix_norm[l], w_in[l], q_norm_a[l],
                              k_norm_a[l], mem_norm[l], w_mem_kv[l], out_norm_a[l],
                              out_norm_b[l], out_norm_m[l], w_out[l], post_mix_norm[l],
                              pre_ffn_norm[l], w_up[l], w_down[l], post_ffn_norm[l])
        return x

    y_prompt = trunk(x_prompt, mem_prompt)
    y_sample = trunk(x_sample, mem_sample)
    return (y_prompt, y_sample)
```

```cpp
#include <hip/hip_runtime.h>
#include <hip/hip_cooperative_groups.h>
#include <cstdio>
#include <cstdint>
namespace cg = cooperative_groups;
namespace pg8 {
#define PG8_LAS __attribute__((address_space(3)))
typedef unsigned short bf16_t;
typedef short bf16x8 __attribute__((ext_vector_type(8)));
typedef float f32x4 __attribute__((ext_vector_type(4)));
typedef unsigned u32x4 __attribute__((ext_vector_type(4)));
constexpr int BM = 256, BK = 64, HALF = 128, HTB = HALF * BK * 2  , STAGE_BYTES = 8 * HTB, NXCD = 8, WGM = 8;

__host__ __device__ __forceinline__ int lds_byte(int r, int c) { const int st = (r >> 4) * 2 + (c >> 5), rr = r & 15, cc = c & 31, ob = rr * 64 + cc * 2; return st * 1024 + (ob ^ (((ob >> 9) & 1) << 5)); }
__host__ __device__ __forceinline__ void stage_rc(int b, int& R, int& C) { const int st = b / 1024, sb = b % 1024, swz = sb ^ (((sb >> 9) & 1) << 5); R = (st >> 1) * 16 + swz / 64; C = (st & 1) * 32 + (swz % 64) / 2; }
__host__ __device__ __forceinline__ int perm32(int rho) { const int n = rho >> 4, i = rho & 15; return 8 * (i >> 2) + 4 * n + (i & 3); }

struct Unit { int pm, pn; };
struct Gemm { const bf16_t* A; const bf16_t* Bt; int M, N, K; };

struct StaticOrder {
    int nM, nN, nwg, G, c;
    __host__ __device__ void init(int M, int N, int G_, int c_) { nM = M / BM; nN = N / BM; nwg = nM * nN; G = G_; c = c_; }
    __host__ __device__ bool next(int i, Unit& u) const {
        const long L = (long)i * G + c; if (L >= nwg) return false;
        int wgid = (int)L; { const int q = nwg / NXCD, r = nwg % NXCD, xcd = wgid % NXCD, off = wgid / NXCD; wgid = (xcd < r ? xcd * (q + 1) : r * (q + 1) + (xcd - r) * q) + off; }
        const int nig = WGM * nN, gid = wgid / nig, fm = gid * WGM, gsz = (nM - fm) < WGM ? (nM - fm) : WGM;
        u.pm = fm + ((wgid % nig) % gsz); u.pn = (wgid % nig) / gsz; return true;
    }
    __device__ __forceinline__ void a_ready(const Unit&) const {}
    __device__ __forceinline__ void done(const Unit&) const {}
};

__device__ __forceinline__ unsigned cvt_pk_bf16(float lo, float hi) { unsigned r; asm volatile("v_cvt_pk_bf16_f32 %0, %1, %2" : "=v"(r) : "v"(lo), "v"(hi)); return r; }
typedef float f32x2 __attribute__((ext_vector_type(2)));
template <int ACT, bool MEMSPLIT> struct EpiOut {
    static constexpr bool PERM = true, AFTER_DRAIN = false;
    static constexpr int SPLIT_PM = 160, SPLIT_PN = 16;
    bf16_t* O; int ldc; bf16_t* O2; int ldc2;
    __device__ __forceinline__ void operator()(const f32x4 (&acc)[2][2][4][2], const Unit& u, int wr, int wc, int fr, int fq) const {
        int row0 = u.pm * BM + wr * 64 + fr; int colt = u.pn * BM; bf16_t* base = O; int ld = ldc;
        if (MEMSPLIT) { if (u.pm >= SPLIT_PM) { base = O2; ld = ldc2; row0 -= SPLIT_PM * BM; colt -= SPLIT_PN * BM; } }
        const int col0 = colt + wc * 32 + 8 * fq;
#pragma unroll
        for (int ai = 0; ai < 2; ++ai)
#pragma unroll
            for (int m = 0; m < 4; ++m) { bf16_t* rowp = base + (size_t)(row0 + ai * HALF + m * 16) * ld + col0;
#pragma unroll
                for (int bj = 0; bj < 2; ++bj) { f32x4 v0 = acc[ai][bj][m][0], v1 = acc[ai][bj][m][1];
                    if (ACT == 2) {
#pragma unroll
                        for (int e = 0; e < 4; ++e) { const float a = fmaxf(v0[e], 0.f), b = fmaxf(v1[e], 0.f); v0[e] = a * a; v1[e] = b * b; } }
                    u32x4 w; w.x = cvt_pk_bf16(v0[0], v0[1]); w.y = cvt_pk_bf16(v0[2], v0[3]); w.z = cvt_pk_bf16(v1[0], v1[1]); w.w = cvt_pk_bf16(v1[2], v1[3]);
                    *(u32x4*)(rowp + bj * HALF) = w; } }
    }
};
struct OrderWithMem {
    StaticOrder so; int nextra;
    __host__ __device__ bool next(int i, Unit& u) const {
        const long L = (long)i * so.G + so.c; if (L < so.nwg) return so.next(i, u);
        const int e = (int)(L - so.nwg); if (e >= nextra) return false;
        u.pm = 160 + e % 20; u.pn = 16 + e / 20; return true;
    }
    __device__ __forceinline__ void a_ready(const Unit&) const {}
    __device__ __forceinline__ void done(const Unit&) const {}
};

template <class Epi, class Sched, bool ALIGN_EPI = false, bool SP2 = false>
__device__ __forceinline__ void gemm_phase(PG8_LAS unsigned char* lds, const Gemm g, const Sched& S, const Epi& E) {
    const int tid = threadIdx.x, wid = __builtin_amdgcn_readfirstlane(tid >> 6), lane = tid & 63, wr = wid >> 2, wc = wid & 3, fr = lane & 15, fq = lane >> 4;
    const int K = g.K, nt = K / BK;
    unsigned voffA[2], voffB[2];
#pragma unroll
    for (int i = 0; i < 2; ++i) { int R, C; stage_rc(tid * 16 + i * 8192, R, C); const int Rb = Epi::PERM ? ((R & ~31) + perm32(R & 31)) : R;
        voffA[i] = (unsigned)(R * K + C) * 2u; voffB[i] = (unsigned)(Rb * K + C) * 2u; }
    const size_t kstep = (size_t)(BK * 2);
    const size_t hstep = (size_t)HALF * K * 2;
    const size_t tstep = 2 * hstep;
    const unsigned ldsw = (unsigned)wid * 1024u;
    const int aoff = lds_byte(wr * 64 + fr, fq * 8), boff = lds_byte(wc * 32 + fr, fq * 8);
#define PG8_SA(b, h) (((b) * 2 + (h)) * HTB)
#define PG8_SB(b, h) ((4 + (b) * 2 + (h)) * HTB)
#define PG8_STAGE(bufoff, gbase, voff) do { _Pragma("unroll") for (int _i = 0; _i < 2; ++_i) \
        __builtin_amdgcn_global_load_lds((const unsigned*)((const char*)(gbase) + (voff)[_i]), (PG8_LAS unsigned*)(lds + (bufoff) + ldsw + _i * 8192), 16, 0, 0); } while (0)
#define PG8_LDA(dst, b, h) do { _Pragma("unroll") for (int m = 0; m < 4; ++m) _Pragma("unroll") for (int k = 0; k < 2; ++k) dst[m][k] = *(const PG8_LAS bf16x8*)(lds + PG8_SA(b, h) + aoff + m * 2048 + k * 1024); } while (0)
#define PG8_LDB(dst, b, h) do { _Pragma("unroll") for (int n = 0; n < 2; ++n) _Pragma("unroll") for (int k = 0; k < 2; ++k) dst[n][k] = *(const PG8_LAS bf16x8*)(lds + PG8_SB(b, h) + boff + n * 2048 + k * 1024); } while (0)
#define PG8_MMA(ai, bj, At, Bt) do { __builtin_amdgcn_s_setprio(1); _Pragma("unroll") for (int m = 0; m < 4; ++m) _Pragma("unroll") for (int n = 0; n < 2; ++n) _Pragma("unroll") for (int k = 0; k < 2; ++k) \
        acc[ai][bj][m][n] = __builtin_amdgcn_mfma_f32_16x16x32_bf16(Bt[n][k], At[m][k], acc[ai][bj][m][n], 0, 0, 0); __builtin_amdgcn_s_setprio(0); } while (0)
#define PG8_WAIT_V(n) asm volatile("s_waitcnt vmcnt(" #n ")" ::: "memory")
#define PG8_WAIT_L(n) asm volatile("s_waitcnt lgkmcnt(" #n ")" ::: "memory")
#define PG8_BAR __builtin_amdgcn_s_barrier()
#define PG8_SCHED __builtin_amdgcn_sched_barrier(0)
    Unit cur, nxt; int ui = 0;
    if (!S.next(0, cur)) return;
    f32x4 acc[2][2][4][2];
#pragma unroll
    for (int a = 0; a < 2; ++a)
#pragma unroll
        for (int b = 0; b < 2; ++b)
#pragma unroll
            for (int m = 0; m < 4; ++m)
#pragma unroll
                for (int n = 0; n < 2; ++n) acc[a][b][m][n] = (f32x4){0.f, 0.f, 0.f, 0.f};
    bf16x8 At[4][2], B0[2][2], B1[2][2];
    const char* cA = (const char*)g.A + (size_t)cur.pm * tstep; const char* cB = (const char*)g.Bt + (size_t)cur.pn * tstep;
    S.a_ready(cur);
    if constexpr (SP2) {
        PG8_STAGE(PG8_SB(0, 0), cB, voffB); PG8_STAGE(PG8_SB(0, 1), cB + hstep, voffB); PG8_STAGE(PG8_SA(0, 0), cA, voffA); PG8_STAGE(PG8_SA(0, 1), cA + hstep, voffA);
        if (wr == 1) PG8_BAR;
        PG8_WAIT_V(2); PG8_BAR;
        PG8_STAGE(PG8_SB(1, 0), cB + kstep, voffB); PG8_STAGE(PG8_SA(1, 0), cA + kstep, voffA); PG8_STAGE(PG8_SB(1, 1), cB + hstep + kstep, voffB);
        PG8_WAIT_V(6); PG8_BAR;
    } else {
        PG8_STAGE(PG8_SB(0, 0), cB, voffB); PG8_STAGE(PG8_SA(0, 0), cA, voffA); PG8_STAGE(PG8_SB(0, 1), cB + hstep, voffB); PG8_STAGE(PG8_SA(0, 1), cA + hstep, voffA);
        if (wr == 1) PG8_BAR;
        PG8_WAIT_V(4); PG8_BAR;
        PG8_STAGE(PG8_SB(1, 0), cB + kstep, voffB); PG8_STAGE(PG8_SA(1, 0), cA + kstep, voffA); PG8_STAGE(PG8_SB(1, 1), cB + hstep + kstep, voffB);
        PG8_WAIT_V(6); PG8_BAR;
    }
    for (;;) {
        const bool has_next = S.next(ui + 1, nxt);
        const char* nA = has_next ? (const char*)g.A + (size_t)nxt.pm * tstep : cA; const char* nB = has_next ? (const char*)g.Bt + (size_t)nxt.pn * tstep : cB;
        for (int t = 0; t < nt; t += 2) {
            const bool last = (t == nt - 2);
            const char* a1 = cA + (size_t)(t + 1) * kstep;
            const char* a2 = last ? nA : cA + (size_t)(t + 2) * kstep; const char* b2 = last ? nB : cB + (size_t)(t + 2) * kstep;
            const char* a3 = a2 + kstep; const char* b3 = b2 + kstep;
            if (last && has_next) S.a_ready(nxt);
            if constexpr (SP2) {
            PG8_LDB(B0, 0, 0); PG8_LDB(B1, 0, 1); PG8_SCHED; PG8_LDA(At, 0, 0); PG8_STAGE(PG8_SA(1, 1), a1 + hstep, voffA);
            PG8_WAIT_V(8); PG8_WAIT_L(0); PG8_BAR; PG8_MMA(0, 0, At, B0); PG8_MMA(0, 1, At, B1); PG8_BAR; PG8_SCHED;
            PG8_LDA(At, 0, 1); PG8_STAGE(PG8_SB(0, 0), b2, voffB); PG8_STAGE(PG8_SB(0, 1), b2 + hstep, voffB); PG8_STAGE(PG8_SA(0, 0), a2, voffA);
            PG8_WAIT_V(8); PG8_WAIT_L(0); PG8_BAR; PG8_MMA(1, 0, At, B0); PG8_MMA(1, 1, At, B1); PG8_BAR; PG8_SCHED;
            PG8_LDB(B0, 1, 0); PG8_LDB(B1, 1, 1); PG8_SCHED; PG8_LDA(At, 1, 0); PG8_STAGE(PG8_SA(0, 1), a2 + hstep, voffA);
            PG8_WAIT_V(8); PG8_WAIT_L(0); PG8_BAR; PG8_MMA(0, 0, At, B0); PG8_MMA(0, 1, At, B1); PG8_BAR; PG8_SCHED;
            PG8_LDA(At, 1, 1); PG8_STAGE(PG8_SB(1, 0), b3, voffB); PG8_STAGE(PG8_SB(1, 1), b3 + hstep, voffB); PG8_STAGE(PG8_SA(1, 0), a3, voffA);
            PG8_WAIT_V(8); PG8_WAIT_L(0); PG8_BAR; PG8_MMA(1, 0, At, B0); PG8_MMA(1, 1, At, B1); PG8_BAR; PG8_SCHED;
            } else {
            PG8_LDB(B0, 0, 0); PG8_SCHED; PG8_LDA(At, 0, 0); PG8_STAGE(PG8_SA(1, 1), a1 + hstep, voffA);
            PG8_WAIT_L(8); PG8_BAR; PG8_WAIT_L(0); PG8_MMA(0, 0, At, B0); PG8_BAR; PG8_SCHED;
            PG8_LDB(B1, 0, 1); PG8_STAGE(PG8_SB(0, 0), b2, voffB);
            PG8_BAR; PG8_WAIT_L(0); PG8_MMA(0, 1, At, B1); PG8_BAR;
            PG8_LDA(At, 0, 1); PG8_STAGE(PG8_SA(0, 0), a2, voffA);
            PG8_BAR; PG8_WAIT_L(0); PG8_MMA(1, 0, At, B0); PG8_BAR; PG8_SCHED;
            PG8_STAGE(PG8_SB(0, 1), b2 + hstep, voffB);
            PG8_WAIT_V(6); PG8_BAR; PG8_MMA(1, 1, At, B1); PG8_BAR;
            PG8_LDB(B0, 1, 0); PG8_SCHED; PG8_LDA(At, 1, 0); PG8_STAGE(PG8_SA(0, 1), a2 + hstep, voffA);
            PG8_WAIT_L(8); PG8_BAR; PG8_WAIT_L(0); PG8_MMA(0, 0, At, B0); PG8_BAR; PG8_SCHED;
            PG8_LDB(B1, 1, 1); PG8_STAGE(PG8_SB(1, 0), b3, voffB);
            PG8_BAR; PG8_WAIT_L(0); PG8_MMA(0, 1, At, B1); PG8_BAR;
            PG8_LDA(At, 1, 1); PG8_STAGE(PG8_SA(1, 0), a3, voffA);
            PG8_BAR; PG8_WAIT_L(0); PG8_MMA(1, 0, At, B0); PG8_BAR; PG8_SCHED;
            PG8_STAGE(PG8_SB(1, 1), b3 + hstep, voffB);
            PG8_WAIT_V(6); PG8_BAR; PG8_MMA(1, 1, At, B1); PG8_BAR;
            }
        }
        if constexpr (ALIGN_EPI) { if (wr == 0) PG8_BAR; }
        if constexpr (!Epi::AFTER_DRAIN) { E(acc, cur, wr, wc, fr, fq); S.done(cur); }
        if (!has_next) break;
#pragma unroll
        for (int a = 0; a < 2; ++a)
#pragma unroll
            for (int b = 0; b < 2; ++b)
#pragma unroll
                for (int m = 0; m < 4; ++m)
#pragma unroll
                    for (int n = 0; n < 2; ++n) acc[a][b][m][n] = (f32x4){0.f, 0.f, 0.f, 0.f};
        cur = nxt; cA = nA; cB = nB; ++ui;
        if constexpr (ALIGN_EPI) { if (wr == 1) PG8_BAR; }
    }
    PG8_WAIT_V(0);
    if constexpr (!ALIGN_EPI) { if (wr == 0) PG8_BAR; }
    PG8_BAR;
    if constexpr (Epi::AFTER_DRAIN) { E.fused(acc, cur, wr, wc, fr, fq, lds, wid, lane); S.done(cur); }
#undef PG8_SA
#undef PG8_SB
#undef PG8_STAGE
#undef PG8_LDA
#undef PG8_LDB
#undef PG8_MMA
#undef PG8_WAIT_V
#undef PG8_WAIT_L
#undef PG8_BAR
#undef PG8_SCHED
}
}
namespace att {
using bf16 = unsigned short;
constexpr int   D = 128, NW = 8, QBLK = 32, KVBLK = 64;
constexpr float SCALE = 0.088388347648318440f;
constexpr float THR = 8.f;
constexpr float MINIT = -30000.f;
constexpr size_t SHM_V = KVBLK * D * 2, SHM_K = KVBLK * D * 2;
constexpr size_t SHM_ATTN = 2 * SHM_V + 2 * SHM_K + NW * 64 * 4 + 1024;
using bf16x8 = __attribute__((ext_vector_type(8))) short;
using s16x4  = __attribute__((ext_vector_type(4))) short;
using f32x16 = __attribute__((ext_vector_type(16))) float;
using u32x4  = __attribute__((ext_vector_type(4))) unsigned;
#define KSWZ(row, colB) ((row) * 256 + ((colB) ^ (((row) & 7) << 4)))
#define SBAR() __builtin_amdgcn_sched_barrier(0)
__device__ __forceinline__ int crow(int r, int hi) { return (r & 3) + 8 * (r >> 2) + 4 * hi; }
__device__ __forceinline__ unsigned cvtpk(float lo, float hi) {
  unsigned r; asm volatile("v_cvt_pk_bf16_f32 %0, %1, %2" : "=v"(r) : "v"(lo), "v"(hi)); return r;
}
__device__ __forceinline__ void partialSM(f32x16& p0, f32x16& p1, float& m_reg, float& mn, float& alpha) {
  constexpr float C = SCALE * 1.4426950408889634f;
  float pmax = p0[0]; for (int r = 1; r < 16; ++r) pmax = fmaxf(pmax, p0[r]); for (int r = 0; r < 16; ++r) pmax = fmaxf(pmax, p1[r]);
  { auto rr = __builtin_amdgcn_permlane32_swap(__float_as_uint(pmax), __float_as_uint(pmax), false, false);
    pmax = fmaxf(__uint_as_float(rr[0]), __uint_as_float(rr[1])); }
  if (__builtin_expect(__all(pmax - m_reg <= THR / SCALE), 1)) { mn = m_reg; alpha = 1.f; }
  else { mn = fmaxf(m_reg, pmax); alpha = __builtin_amdgcn_exp2f((m_reg - mn) * C); m_reg = mn; }
  float mnC = -mn * C;
  for (int r = 0; r < 16; ++r) p0[r] = fmaf(p0[r], C, mnC); for (int r = 0; r < 16; ++r) p1[r] = fmaf(p1[r], C, mnC);
  for (int r = 0; r < 16; ++r) p0[r] = __builtin_amdgcn_exp2f(p0[r]);
}
__device__ __forceinline__ void finishSM(f32x16& p0, f32x16& p1, float alpha, float& l_reg, bf16x8& pa0, bf16x8& pa1, bf16x8& pa2, bf16x8& pa3) {
  for (int r = 0; r < 16; ++r) p1[r] = __builtin_amdgcn_exp2f(p1[r]);
  float ps = 0; for (int r = 0; r < 16; ++r) ps += p0[r]; for (int r = 0; r < 16; ++r) ps += p1[r];
  { auto rr = __builtin_amdgcn_permlane32_swap(__float_as_uint(ps), __float_as_uint(ps), false, false);
    ps = __uint_as_float(rr[0]) + __uint_as_float(rr[1]); }
  l_reg = l_reg * alpha + ps;
#define PK4(P, BASE, OUT) do { unsigned a0 = cvtpk(P[BASE + 0], P[BASE + 1]), a1 = cvtpk(P[BASE + 2], P[BASE + 3]);   \
    unsigned b0 = cvtpk(P[BASE + 4], P[BASE + 5]), b1 = cvtpk(P[BASE + 6], P[BASE + 7]);                              \
    auto r0 = __builtin_amdgcn_permlane32_swap(a0, b0, false, false); auto r1 = __builtin_amdgcn_permlane32_swap(a1, b1, false, false); \
    u32x4 w = {r0[0], r1[0], r0[1], r1[1]}; OUT = *reinterpret_cast<bf16x8*>(&w); } while (0)
  PK4(p0, 0, pa0); PK4(p0, 8, pa1); PK4(p1, 0, pa2); PK4(p1, 8, pa3);
#undef PK4
}
__device__ __forceinline__ void qkt(f32x16& p0, f32x16& p1, const bf16* Ks, const bf16x8* qr, int r32, int hi) {
  p0 = f32x16{}; p1 = f32x16{};
  for (int d0 = 0; d0 < 8; ++d0) { int cb = (d0 * 16 + hi * 8) * 2;
    bf16x8 b0 = *reinterpret_cast<const bf16x8*>((const char*)Ks + KSWZ(r32, cb));
    bf16x8 b1 = *reinterpret_cast<const bf16x8*>((const char*)Ks + KSWZ(32 + r32, cb));
    p0 = __builtin_amdgcn_mfma_f32_32x32x16_bf16(b0, qr[d0], p0, 0, 0, 0);
    p1 = __builtin_amdgcn_mfma_f32_32x32x16_bf16(b1, qr[d0], p1, 0, 0, 0); }
}
__device__ __forceinline__ int v_st(int k, int c) { const int kk = (k & ~0xC) | ((k & 4) << 1) | ((k & 8) >> 1); return ((kk >> 3) * 4 + (c >> 5)) * 512 + ((kk & 7) * 32 + (c & 31)) * 2; }
__device__ __forceinline__ int v_rd_base(int lane) { return ((lane & 3) << 3) | (((lane >> 2) & 3) << 6) | (((lane >> 4) & 1) << 5) | (((lane >> 5) & 1) << 8); }
constexpr int v_rd_off(int d0, int ks, int half) { return d0 * 512 + ks * 4096 + half * 2048; }
template <int OFF> __device__ __forceinline__ s16x4 tr_read(int vb) {
  s16x4 r; asm volatile("ds_read_b64_tr_b16 %0, %1 offset:%2" : "=&v"(r) : "v"(vb), "i"(OFF) : "memory"); return r;
}
template <int D0> __device__ __forceinline__ void pv_one(f32x16& od, int vb, bf16x8 pa0, bf16x8 pa1, bf16x8 pa2, bf16x8 pa3) {
  const s16x4 l0 = tr_read<v_rd_off(D0, 0, 0)>(vb), h0 = tr_read<v_rd_off(D0, 0, 1)>(vb), l1 = tr_read<v_rd_off(D0, 1, 0)>(vb), h1 = tr_read<v_rd_off(D0, 1, 1)>(vb);
  const s16x4 l2 = tr_read<v_rd_off(D0, 2, 0)>(vb), h2 = tr_read<v_rd_off(D0, 2, 1)>(vb), l3 = tr_read<v_rd_off(D0, 3, 0)>(vb), h3 = tr_read<v_rd_off(D0, 3, 1)>(vb);
  asm volatile("s_waitcnt lgkmcnt(0)" ::: "memory"); SBAR();
#define PK(L, H) (bf16x8){L[0], L[1], L[2], L[3], H[0], H[1], H[2], H[3]}
  od = __builtin_amdgcn_mfma_f32_32x32x16_bf16(pa0, PK(l0, h0), od, 0, 0, 0);
  od = __builtin_amdgcn_mfma_f32_32x32x16_bf16(pa1, PK(l1, h1), od, 0, 0, 0);
  od = __builtin_amdgcn_mfma_f32_32x32x16_bf16(pa2, PK(l2, h2), od, 0, 0, 0);
  od = __builtin_amdgcn_mfma_f32_32x32x16_bf16(pa3, PK(l3, h3), od, 0, 0, 0);
#undef PK
}
__device__ __forceinline__ void pv_d0(f32x16* o, int vb, bf16x8 pa0, bf16x8 pa1, bf16x8 pa2, bf16x8 pa3) {
  pv_one<0>(o[0], vb, pa0, pa1, pa2, pa3); pv_one<1>(o[1], vb, pa0, pa1, pa2, pa3); pv_one<2>(o[2], vb, pa0, pa1, pa2, pa3); pv_one<3>(o[3], vb, pa0, pa1, pa2, pa3);
}
__device__ __forceinline__ void band_mask(f32x16& p0, f32x16& p1, int base, int hi, const float* biasL) {
#pragma unroll
  for (int r = 0; r < 16; ++r) {
    const int k0 = base + crow(r, hi), k1 = k0 + 32;
    const int c0 = min(max(k0, 0), 128), c1 = min(max(k1, 0), 128);
    const float b0 = biasL[c0], b1 = biasL[c1];
    p0[r] = ((unsigned)k0 <= 128u) ? p0[r] + b0 : MINIT;
    p1[r] = ((unsigned)k1 <= 128u) ? p1[r] + b1 : MINIT;
  }
}
__device__ __forceinline__ unsigned short f2bf(float f) { unsigned u = __builtin_bit_cast(unsigned, f); return (unsigned short)((u + 0x7fffu + ((u >> 16) & 1u)) >> 16); }

template <int MODE>
__device__ __forceinline__ void attn_unit(const bf16* __restrict__ Qh, const bf16* __restrict__ Kh, const bf16* __restrict__ Vh, bf16* __restrict__ Oh,
                                          float* __restrict__ lse_o, const int ldk, const int NT, const int dil, const int two, const int m0, const int ms,
                                          const float* __restrict__ bias_g, char* lds) {
  constexpr int LDQ = 4096, LDO = 2048;
  const int tid = threadIdx.x, wid = tid >> 6, lane = tid & 63, r32 = lane & 31, hi = lane >> 5;
  bf16* V_lds = (bf16*)lds; bf16* K_lds = (bf16*)(lds + 2 * SHM_V);
  float* ws = (float*)(lds + 2 * SHM_V + 2 * SHM_K) + wid * 64; float* li_l = ws; float* al_l = ws + 32;
  float* biasL = (float*)(lds + 2 * SHM_V + 2 * SHM_K + NW * 64 * 4);
  float m_reg = MINIT, l_reg = 0; f32x16 o[4] = {}; bf16x8 qr[8];
  const int qi = wid * QBLK + r32;
  int qt = qi, qpos = 0;
  if (MODE == 1) { qt = two ? ((qi & 127) * dil + (qi >> 7)) : qi * dil; qpos = two ? ((qi & 127) + 4096 * (qi >> 7)) : (m0 + qi); }
  const bf16* Qw = Qh + (long)qt * LDQ + hi * 8;
#pragma unroll
  for (int d0 = 0; d0 < 8; ++d0) qr[d0] = *reinterpret_cast<const bf16x8*>(Qw + d0 * 16);
  if (MODE == 1) {
    if (tid < 129) {
      const int rel = (tid - 64) * dil, n = rel < 0 ? -rel : rel; const float nf = (float)(n > 1 ? n : 1);
      int large = 8 + (int)(logf(nf * 0.125f) / 4.852030263919617f * 8.0f); large = large < 15 ? large : 15;
      const int bucket = (rel > 0 ? 16 : 0) + (n < 8 ? n : large);
      biasL[tid] = bias_g[bucket * 6] * (1.0f / SCALE);
    }
  }
  const int rs = (MODE == 1) ? dil : 1;
  const int sr = tid >> 4, sc = (tid & 15) * 8, vst0 = v_st(sr, sc), vst1 = v_st(32 + sr, sc);
  const int vb0 = (int)(uintptr_t)V_lds + v_rd_base(lane);
  const unsigned lo0 = (unsigned)(sr * rs * ldk + sc), lo1 = lo0 + (unsigned)(32 * rs * ldk);
  constexpr int SDEPTH = (MODE == 1) ? 1 : 2;
  struct { bf16x8 vs0, vs1, ks0, ks1; } sr_[SDEPTH];
#define KTOK0(j) ((MODE == 0) ? 64 * (j) : (two ? ((64 * ((j) & 1)) * dil + ((j) >> 1)) : (ms + 64 * (j)) * dil))
#define KPOS0(j) (two ? (64 * ((j) & 1) + 4096 * ((j) >> 1)) : (ms + 64 * (j)))
#define SLOAD(i, j) do { const long tb_ = (long)__builtin_amdgcn_readfirstlane(KTOK0(j)) * ldk; const bf16* kt_ = Kh + tb_; const bf16* vt_ = Vh + tb_; \
    sr_[i].vs0 = *reinterpret_cast<const bf16x8*>(vt_ + lo0); sr_[i].vs1 = *reinterpret_cast<const bf16x8*>(vt_ + lo1); \
    sr_[i].ks0 = *reinterpret_cast<const bf16x8*>(kt_ + lo0); sr_[i].ks1 = *reinterpret_cast<const bf16x8*>(kt_ + lo1); } while (0)
#define SWRITE(b, i) do { *(bf16x8*)((char*)V_lds + (b) * SHM_V + vst0) = sr_[i].vs0;          \
    *(bf16x8*)((char*)V_lds + (b) * SHM_V + vst1) = sr_[i].vs1; int kc = sc * 2;               \
    *(bf16x8*)((char*)K_lds + (b) * SHM_K + KSWZ(sr, kc)) = sr_[i].ks0;                       \
    *(bf16x8*)((char*)K_lds + (b) * SHM_K + KSWZ(32 + sr, kc)) = sr_[i].ks1; } while (0)
#define SWAIT() do { if constexpr (SDEPTH == 2) asm volatile("s_waitcnt vmcnt(4)" ::: "memory"); else asm volatile("s_waitcnt vmcnt(0)" ::: "memory"); } while (0)
#define RESC(a) do { if (__any((a) < 1.f)) { if (hi == 0) al_l[r32] = (a); asm volatile("s_waitcnt lgkmcnt(0)" ::: "memory"); \
    for (int d = 0; d < 4; ++d) for (int r = 0; r < 16; ++r) o[d][r] *= al_l[crow(r, hi)]; } } while (0)
#define MASK(P0, P1, j) do { if (MODE == 1) band_mask(P0, P1, KPOS0(j) - qpos + 64, hi, biasL); } while (0)
  f32x16 pA0, pA1, pB0, pB1; float mnA, mnB, alA, alB; bf16x8 pa0, pa1, pa2, pa3;
  constexpr int SE = 0, SO = SDEPTH - 1;
  SLOAD(SE, 0); asm volatile("s_waitcnt vmcnt(0)" ::: "memory"); SWRITE(0, SE); __syncthreads();
  qkt(pA0, pA1, K_lds, qr, r32, hi); MASK(pA0, pA1, 0); partialSM(pA0, pA1, m_reg, mnA, alA);
  SLOAD(SO, 1); if constexpr (SDEPTH == 2) { if (2 < NT) SLOAD(SE, 2); }
  SWAIT(); SWRITE(1, SO); __syncthreads();
  for (int j = 1; j + 1 < NT; j += 2) {
    SBAR(); qkt(pB0, pB1, (bf16*)((char*)K_lds + SHM_K), qr, r32, hi);
    finishSM(pA0, pA1, alA, l_reg, pa0, pa1, pa2, pa3); SBAR();
    SLOAD(SO, j + SDEPTH); SBAR();
    pv_d0(o, vb0, pa0, pa1, pa2, pa3); MASK(pB0, pB1, j); partialSM(pB0, pB1, m_reg, mnB, alB);
    __syncthreads(); SWAIT(); SWRITE(0, SE);
    RESC(alB); __syncthreads();
    SBAR(); qkt(pA0, pA1, K_lds, qr, r32, hi);
    finishSM(pB0, pB1, alB, l_reg, pa0, pa1, pa2, pa3); SBAR();
    if (SDEPTH == 1 || j + 3 < NT) SLOAD(SE, j + 1 + SDEPTH); SBAR();
    pv_d0(o, vb0 + (int)SHM_V, pa0, pa1, pa2, pa3); MASK(pA0, pA1, j + 1); partialSM(pA0, pA1, m_reg, mnA, alA);
    __syncthreads(); SWAIT(); SWRITE(1, SO);
    RESC(alA); __syncthreads();
  }
  SBAR(); qkt(pB0, pB1, (bf16*)((char*)K_lds + SHM_K), qr, r32, hi);
  finishSM(pA0, pA1, alA, l_reg, pa0, pa1, pa2, pa3); SBAR();
  pv_d0(o, vb0, pa0, pa1, pa2, pa3); MASK(pB0, pB1, NT - 1); partialSM(pB0, pB1, m_reg, mnB, alB);
  __syncthreads(); RESC(alB);
  finishSM(pB0, pB1, alB, l_reg, pa0, pa1, pa2, pa3); SBAR();
  pv_d0(o, vb0 + (int)SHM_V, pa0, pa1, pa2, pa3);
  if (hi == 0) li_l[r32] = l_reg; asm volatile("s_waitcnt lgkmcnt(0)" ::: "memory");
  float rli[16];
#pragma unroll
  for (int r = 0; r < 16; ++r) rli[r] = __builtin_amdgcn_rcpf(li_l[crow(r, hi)]);
#pragma unroll
  for (int r = 0; r < 16; ++r) { const int qo = wid * QBLK + crow(r, hi);
    long ot = qo; if (MODE == 1) ot = two ? ((qo & 127) * dil + (qo >> 7)) : qo * dil;
    bf16* Ow = Oh + ot * LDO + r32;
#pragma unroll
    for (int d0 = 0; d0 < 4; ++d0) Ow[d0 * 32] = f2bf(o[d0][r] * rli[r]); }
  if (MODE == 1) { if (hi == 0) lse_o[(long)qt * 6] = m_reg * SCALE + logf(l_reg); }
#undef KTOK0
#undef KPOS0
#undef SLOAD
#undef SWRITE
#undef SWAIT
#undef RESC
#undef MASK
}

__device__ __forceinline__ void attn_unit_band(const bf16* __restrict__ Qh, const bf16* __restrict__ Kh, const bf16* __restrict__ Vh, bf16* __restrict__ Oh,
                                               float* __restrict__ lse_o, const int ldk, const int NT, const int dil, const int two, const int m0, const int ms,
                                               const float* __restrict__ bias_g, char* lds) {
  constexpr int LDQ = 4096, LDO = 2048;
  const int tid = threadIdx.x, wid = tid >> 6, lane = tid & 63, r32 = lane & 31, hi = lane >> 5;
  bf16* V_lds = (bf16*)lds; bf16* K_lds = (bf16*)(lds + 2 * SHM_V);
  float* ws = (float*)(lds + 2 * SHM_V + 2 * SHM_K) + wid * 64; float* li_l = ws; float* al_l = ws + 32;
  float* biasL = (float*)(lds + 2 * SHM_V + 2 * SHM_K + NW * 64 * 4);
  float m_reg = MINIT, l_reg = 0; f32x16 o[4] = {}; bf16x8 qr[8];
  const int qi = wid * QBLK + r32;
  const int qt = two ? ((qi & 127) * dil + (qi >> 7)) : qi * dil, qpos = two ? ((qi & 127) + 4096 * (qi >> 7)) : (m0 + qi);
  const bf16* Qw = Qh + (long)qt * LDQ + hi * 8;
#pragma unroll
  for (int d0 = 0; d0 < 8; ++d0) qr[d0] = *reinterpret_cast<const bf16x8*>(Qw + d0 * 16);
  if (tid < 129) {
    const int rel = (tid - 64) * dil, n = rel < 0 ? -rel : rel; const float nf = (float)(n > 1 ? n : 1);
    int large = 8 + (int)(logf(nf * 0.125f) / 4.852030263919617f * 8.0f); large = large < 15 ? large : 15;
    const int bucket = (rel > 0 ? 16 : 0) + (n < 8 ? n : large);
    biasL[tid] = bias_g[bucket * 6] * (1.0f / SCALE);
  }
  const int sr = tid >> 4, sc = (tid & 15) * 8, vst0 = v_st(sr, sc), vst1 = v_st(32 + sr, sc);
  const int vb0 = (int)(uintptr_t)V_lds + v_rd_base(lane);
  const unsigned lo0 = (unsigned)(sr * dil * ldk + sc), lo1 = lo0 + (unsigned)(32 * dil * ldk);
  bf16x8 vs0, vs1, ks0, ks1;
#define KTOK0(j) (two ? ((64 * ((j) & 1)) * dil + ((j) >> 1)) : (ms + 64 * (j)) * dil)
#define KPOS0(j) (two ? (64 * ((j) & 1) + 4096 * ((j) >> 1)) : (ms + 64 * (j)))
#define SLOAD(j) do { const long tb_ = (long)__builtin_amdgcn_readfirstlane(KTOK0(j)) * ldk; const bf16* kt_ = Kh + tb_; const bf16* vt_ = Vh + tb_; \
    vs0 = *reinterpret_cast<const bf16x8*>(vt_ + lo0); vs1 = *reinterpret_cast<const bf16x8*>(vt_ + lo1); \
    ks0 = *reinterpret_cast<const bf16x8*>(kt_ + lo0); ks1 = *reinterpret_cast<const bf16x8*>(kt_ + lo1); } while (0)
  SLOAD(0);
  for (int j = 0; j < NT; ++j) {
    asm volatile("s_waitcnt vmcnt(0)" ::: "memory");
    __syncthreads();
    *(bf16x8*)((char*)V_lds + vst0) = vs0; *(bf16x8*)((char*)V_lds + vst1) = vs1;
    *(bf16x8*)((char*)K_lds + KSWZ(sr, sc * 2)) = ks0; *(bf16x8*)((char*)K_lds + KSWZ(32 + sr, sc * 2)) = ks1;
    __syncthreads();
    if (j + 1 < NT) SLOAD(j + 1);
    f32x16 p0, p1; float mn, al; bf16x8 pa0, pa1, pa2, pa3;
    SBAR(); qkt(p0, p1, K_lds, qr, r32, hi);
    band_mask(p0, p1, KPOS0(j) - qpos + 64, hi, biasL);
    partialSM(p0, p1, m_reg, mn, al);
    if (__any(al < 1.f)) { if (hi == 0) al_l[r32] = al; asm volatile("s_waitcnt lgkmcnt(0)" ::: "memory");
#pragma unroll
      for (int d = 0; d < 4; ++d)
#pragma unroll
        for (int r = 0; r < 16; ++r) o[d][r] *= al_l[crow(r, hi)]; }
    finishSM(p0, p1, al, l_reg, pa0, pa1, pa2, pa3); SBAR();
    pv_d0(o, vb0, pa0, pa1, pa2, pa3);
  }
  if (hi == 0) li_l[r32] = l_reg; asm volatile("s_waitcnt lgkmcnt(0)" ::: "memory");
  float rli[16];
#pragma unroll
  for (int r = 0; r < 16; ++r) rli[r] = __builtin_amdgcn_rcpf(li_l[crow(r, hi)]);
#pragma unroll
  for (int r = 0; r < 16; ++r) { const int qo = wid * QBLK + crow(r, hi);
    const long ot = two ? ((qo & 127) * dil + (qo >> 7)) : qo * dil;
    bf16* Ow = Oh + ot * LDO + r32;
#pragma unroll
    for (int d0 = 0; d0 < 4; ++d0) Ow[d0 * 32] = f2bf(o[d0][r] * rli[r]); }
  if (hi == 0) lse_o[(long)qt * 6] = m_reg * SCALE + logf(l_reg);
#undef KTOK0
#undef KPOS0
#undef SLOAD
}
#undef KSWZ
#undef SBAR
}
#define LAS __attribute__((address_space(3)))
typedef unsigned short bf16;
typedef float f32x4 __attribute__((ext_vector_type(4)));
typedef unsigned u32x4 __attribute__((ext_vector_type(4)));
typedef float f32x2 __attribute__((ext_vector_type(2)));

constexpr int NWAVES = 8;
constexpr int DM = 2048, SEQ = 2048, NB_P = 4, NB_S = 16, NBATCH = NB_P + NB_S;
constexpr int TOK_P = NB_P * SEQ, TOK = NBATCH * SEQ;
constexpr int NMEM = 256, MEMROWS = NBATCH * NMEM;
constexpr int INC = 4096, DFF = 8192, MEMKV = 1024;
constexpr int C_QA = 0, C_KA = 768, C_VA = 1024, C_QB = 1280, C_KB = 2048, C_VB = 2816, C_QM = 3584;
constexpr float EPS = 1e-6f;

constexpr size_t MiB = 1u << 20;
constexpr size_t WS_ROPE = 1 * MiB;
constexpr size_t WS_WIN = 2 * MiB, WS_WMEM = 18 * MiB;
constexpr size_t WS_WOUT = 22 * MiB, WS_WUP = 30 * MiB, WS_WDOWN = 62 * MiB;
constexpr size_t WS_LSE = 94 * MiB;
constexpr size_t WS_KVM = 96 * MiB;
constexpr size_t WS_H = 112 * MiB, WS_MEMN = 272 * MiB;
constexpr size_t WS_U = 296 * MiB;
constexpr size_t WS_END = WS_U + (size_t)TOK * DFF * 2;
static_assert(WS_WMEM == WS_WIN + (size_t)INC * DM * 2 && WS_MEMN == WS_H + (size_t)TOK * DM * 2, "contiguous operands");
static_assert(WS_LSE + (size_t)TOK * 6 * 4 <= WS_KVM && WS_KVM + (size_t)MEMROWS * MEMKV * 2 <= WS_H && WS_MEMN + (size_t)MEMROWS * DM * 2 <= WS_U, "ws map");

constexpr int RING_BYTES = 131072;
constexpr int LDS_BYTES = 147456;
static_assert(att::SHM_ATTN <= RING_BYTES && pg8::STAGE_BYTES <= RING_BYTES, "LDS map");

__device__ __forceinline__ float wave_sum(float v) {
#pragma unroll
    for (int o = 1; o < 64; o <<= 1) v += __shfl_xor(v, o);
    return v;
}
__device__ __forceinline__ unsigned f2bf(float f) { unsigned u = __builtin_bit_cast(unsigned, f); return (u + 0x7fffu + ((u >> 16) & 1u)) >> 16; }
__device__ __forceinline__ unsigned pk2(float lo, float hi) { return f2bf(lo) | (f2bf(hi) << 16); }
__device__ __forceinline__ float bflo(unsigned w) { return __uint_as_float(w << 16); }
__device__ __forceinline__ float bfhi(unsigned w) { return __uint_as_float(w & 0xffff0000u); }
__device__ __forceinline__ u32x4 pack8(const f32x4 a, const f32x4 b) { u32x4 o; o.x = pk2(a.x, a.y); o.y = pk2(a.z, a.w); o.z = pk2(b.x, b.y); o.w = pk2(b.z, b.w); return o; }
__device__ __forceinline__ void unpack8(const u32x4 w, f32x4& a, f32x4& b) { a = (f32x4){bflo(w.x), bfhi(w.x), bflo(w.y), bfhi(w.y)}; b = (f32x4){bflo(w.z), bfhi(w.z), bflo(w.w), bfhi(w.w)}; }
__device__ __forceinline__ float sumsq4(const f32x4 a) { return (a.x * a.x + a.y * a.y) + (a.z * a.z + a.w * a.w); }

__device__ __forceinline__ void p0_transpose_item(const float* __restrict__ W, int K, int N, bf16* __restrict__ WT, LAS float* scr, int item, int lane) {
    const int nblk = N / 32, kb = item / nblk, nb = item % nblk, k0 = 64 * kb, n0 = 32 * nb;
#pragma unroll 8
    for (int i = 0; i < 32; ++i) { const int kk = 2 * i + (lane >> 5); scr[kk * 33 + (lane & 31)] = W[(size_t)(k0 + kk) * N + n0 + (lane & 31)]; }
    asm volatile("s_waitcnt lgkmcnt(0)" ::: "memory");
    const int c = lane & 7;
#pragma unroll
    for (int j = 0; j < 4; ++j) { const int n = (lane >> 3) + 8 * j; const LAS float* s = scr + (8 * c) * 33 + n;
        u32x4 o; o.x = pk2(s[0 * 33], s[1 * 33]); o.y = pk2(s[2 * 33], s[3 * 33]); o.z = pk2(s[4 * 33], s[5 * 33]); o.w = pk2(s[6 * 33], s[7 * 33]);
        *(u32x4*)(WT + (size_t)(n0 + n) * K + k0 + 8 * c) = o; }
    asm volatile("s_waitcnt lgkmcnt(0)" ::: "memory");
}

__device__ __forceinline__ void rms_row_to_bf16(const float* __restrict__ src, const float* __restrict__ g, bf16* __restrict__ dst, int lane) {
    f32x4 v[4][2]; float ss = 0.f;
#pragma unroll
    for (int j = 0; j < 4; ++j) { const float* p = src + 8 * (lane + 64 * j); v[j][0] = *(const f32x4*)p; v[j][1] = *(const f32x4*)(p + 4); ss += sumsq4(v[j][0]) + sumsq4(v[j][1]); }
    const float rstd = 1.0f / sqrtf(wave_sum(ss) * (1.0f / DM) + EPS);
#pragma unroll
    for (int j = 0; j < 4; ++j) { const int c = 8 * (lane + 64 * j); const f32x4 g0 = *(const f32x4*)(g + c), g1 = *(const f32x4*)(g + c + 4);
        *(u32x4*)(dst + c) = pack8(v[j][0] * rstd * g0, v[j][1] * rstd * g1); }
}

struct Args { const float* in[20]; float* out; unsigned char* ws; int ph_lo, ph_hi; };
constexpr int N_PHASES = 10;

__global__ void __launch_bounds__(NWAVES * 64, 2) mk_fwd(Args args) {
    extern __shared__ __attribute__((aligned(16))) unsigned char lds[];
    cg::grid_group grid = cg::this_grid();
    const int tid = threadIdx.x, lane = tid & 63, wave = __builtin_amdgcn_readfirstlane(tid >> 6);
    const int G = gridDim.x, bid = blockIdx.x;
    const int gw = bid * NWAVES + wave, NGW = G * NWAVES;
    unsigned char* ws = args.ws;
    const float* x_p = args.in[0]; const float* x_s = args.in[1]; const float* mem_p = args.in[2]; const float* mem_s = args.in[3];
    const float* rel_bias = args.in[4]; const float* g_premix = args.in[5]; const float* w_in = args.in[6]; const float* g_qn = args.in[7]; const float* g_kn = args.in[8];
    const float* g_mem = args.in[9]; const float* w_mem = args.in[10]; const float* g_oa = args.in[11]; const float* g_ob = args.in[12]; const float* g_om = args.in[13];
    const float* w_out = args.in[14]; const float* g_postmix = args.in[15]; const float* g_preffn = args.in[16]; const float* w_up = args.in[17]; const float* w_down = args.in[18];
    const float* g_postffn = args.in[19];
    float* out = args.out;
    f32x2* ROPE = (f32x2*)(ws + WS_ROPE);
    bf16* WIN = (bf16*)(ws + WS_WIN); bf16* WMEM = (bf16*)(ws + WS_WMEM); bf16* WOUT = (bf16*)(ws + WS_WOUT); bf16* WUP = (bf16*)(ws + WS_WUP); bf16* WDOWN = (bf16*)(ws + WS_WDOWN);
    float* LSE = (float*)(ws + WS_LSE); bf16* KVM = (bf16*)(ws + WS_KVM); bf16* H = (bf16*)(ws + WS_H); bf16* U = (bf16*)(ws + WS_U);
    bf16* QKV = U; bf16* Y3 = U; bf16* MIX = H; bf16* H2 = H; bf16* Y5 = H;
    LAS unsigned char* ldsl = (LAS unsigned char*)lds;
    const int lo = args.ph_lo, hi = args.ph_hi;
#define IN(k) (lo <= (k) && (k) < hi)
#define SEAM(k) do { if (IN(k) && IN((k) + 1)) grid.sync(); } while (0)
#define XROW(m) ((m) < TOK_P ? x_p + (size_t)(m) * DM : x_s + (size_t)((m) - TOK_P) * DM)

    if (IN(0)) {
        LAS float* scr = (LAS float*)(ldsl + wave * 16384);
        constexpr int I_IN = (DM / 64) * (INC / 32), I_MEM = (DM / 64) * (MEMKV / 32), I_OUT = (DM / 64) * (DM / 32), I_UP = (DM / 64) * (DFF / 32), I_DN = (DFF / 64) * (DM / 32);
        constexpr int NITEMS = I_IN + I_MEM + I_OUT + I_UP + I_DN;
        for (int it = gw; it < NITEMS; it += NGW) {
            int r = it;
            if (r < I_IN) { p0_transpose_item(w_in, DM, INC, WIN, scr, r, lane); continue; } r -= I_IN;
            if (r < I_MEM) { p0_transpose_item(w_mem, DM, MEMKV, WMEM, scr, r, lane); continue; } r -= I_MEM;
            if (r < I_OUT) { p0_transpose_item(w_out, DM, DM, WOUT, scr, r, lane); continue; } r -= I_OUT;
            if (r < I_UP) { p0_transpose_item(w_up, DM, DFF, WUP, scr, r, lane); continue; } r -= I_UP;
            p0_transpose_item(w_down, DFF, DM, WDOWN, scr, r, lane);
        }
        { const int gt = bid * (NWAVES * 64) + tid; if (gt < 64 * 32) { const int pos = gt >> 5, j = gt & 31; const float inv = powf(10000.0f, -(2.0f * (float)j) / 64.0f); const float ang = (float)pos * inv;
            ROPE[gt] = (f32x2){cosf(ang), sinf(ang)}; } }
        for (int m = gw; m < TOK + MEMROWS; m += NGW) {
            const float* src; const float* g = g_premix;
            if (m < TOK) src = XROW(m);
            else { const int mm = m - TOK; g = g_mem; src = mm < NB_P * NMEM ? mem_p + (size_t)mm * DM : mem_s + (size_t)(mm - NB_P * NMEM) * DM; }
            rms_row_to_bf16(src, g, H + (size_t)m * DM, lane);
        }
    }
    SEAM(0);

    if (IN(1)) {
        pg8::Gemm g{H, WIN, TOK + MEMROWS, INC + MEMKV, DM}; pg8::OrderWithMem S; S.so.init(TOK, INC, G, bid); S.nextra = (MEMROWS / 256) * (MEMKV / 256);
        pg8::EpiOut<0, true> E{QKV, INC, KVM, MEMKV};
        pg8::gemm_phase<pg8::EpiOut<0, true>, pg8::OrderWithMem, true, true>(ldsl, g, S, E);
    }
    SEAM(1);

    if (IN(2)) {
        const int half = lane >> 5, j = lane & 31;
        const float gq1 = g_qn[64 * half + j], gq2 = g_qn[64 * half + j + 32], gk1 = g_kn[64 * half + j], gk2 = g_kn[64 * half + j + 32];
        for (int t = gw; t < TOK; t += NGW) {
            const int s = t & (SEQ - 1); const int pos = half ? (s & 63) : (s >> 6);
            const f32x2 cs = ROPE[pos * 32 + j];
            bf16* row = QKV + (size_t)t * INC + 64 * half + j;
#pragma unroll
            for (int h8 = 0; h8 < 8; ++h8) {
                const float x1 = bflo((unsigned)row[h8 * 128]), x2 = bflo((unsigned)row[h8 * 128 + 32]);
                const float rstd = 1.0f / sqrtf(wave_sum(x1 * x1 + x2 * x2) * (1.0f / 128.0f) + EPS);
                const float a1 = x1 * rstd * (h8 < 6 ? gq1 : gk1), a2 = x2 * rstd * (h8 < 6 ? gq2 : gk2);
                row[h8 * 128] = (bf16)f2bf(a1 * cs.x - a2 * cs.y); row[h8 * 128 + 32] = (bf16)f2bf(a2 * cs.x + a1 * cs.y);
            }
        }
    }
    SEAM(2);

    if (IN(3)) {
        constexpr int NA = NBATCH * 6 * 8, NBU = NBATCH * 6 * 8, NMU = NBATCH * 4 * 8;
        for (int u = bid; u < NA; u += G) {
            const int qb = u & 7, hq = (u >> 3) % 6, b = u / 48; const size_t r0 = (size_t)b * SEQ;
            att::attn_unit<0>(QKV + (r0 + qb * 256) * INC + C_QA + hq * 128, QKV + r0 * INC + C_KA + (hq / 3) * 128, QKV + r0 * INC + C_VA + (hq / 3) * 128,
                              MIX + (r0 + qb * 256) * DM + hq * 128, nullptr, INC, SEQ / 64, 1, 0, 0, 0, nullptr, (char*)lds);
        }
        __syncthreads();
        for (int v = (bid + 64) % G; v < NBU; v += G) {
            const int chunk = v & 7, head = (v >> 3) % 6, b = v / 48, gi = head >> 1; const size_t r0 = (size_t)b * SEQ;
            int dil, two, m0, ms, c, NT;
            if (gi == 0) { dil = 1; two = 0; c = 0; m0 = 256 * chunk; NT = 6; ms = min(max(m0 - 64, 0), SEQ - 384); }
            else if (gi == 1) { dil = 4; two = 0; c = chunk >> 1; m0 = 256 * (chunk & 1); NT = 6; ms = min(max(m0 - 64, 0), SEQ / 4 - 384); }
            else { dil = 16; two = 1; c = 2 * chunk; m0 = 0; ms = 0; NT = 4; }
            const size_t rq = r0 + c + (size_t)m0 * dil, rk = r0 + c;
            att::attn_unit_band(QKV + rq * INC + C_QB + head * 128, QKV + rk * INC + C_KB + head * 128, QKV + rk * INC + C_VB + head * 128,
                                MIX + rq * DM + 768 + head * 128, LSE + rq * 6 + head, INC, NT, dil, two, m0, ms, rel_bias + head, (char*)lds);
        }
        __syncthreads();
        for (int v = (bid + 128) % G; v < NMU; v += G) {
            const int qb = v & 7, hm = (v >> 3) & 3, b = v >> 5; const size_t r0 = (size_t)b * SEQ;
            att::attn_unit<0>(QKV + (r0 + qb * 256) * INC + C_QM + hm * 128, KVM + (size_t)b * NMEM * MEMKV + hm * 128, KVM + (size_t)b * NMEM * MEMKV + 512 + hm * 128,
                              MIX + (r0 + qb * 256) * DM + 1536 + hm * 128, nullptr, MEMKV, NMEM / 64, 1, 0, 0, 0, nullptr, (char*)lds);
        }
    }
    SEAM(3);

    if (IN(4)) {
        for (int t = gw; t < TOK; t += NGW) {
            bf16* row = MIX + (size_t)t * DM; const float* ls = LSE + (size_t)t * 6;
            float al[6];
            { float l[6];
#pragma unroll
              for (int i = 0; i < 6; ++i) l[i] = ls[i];
#pragma unroll
              for (int hp = 0; hp < 2; ++hp) { const float mx = fmaxf(fmaxf(l[hp], l[2 + hp]), l[4 + hp]);
                const float e0 = __expf(l[hp] - mx), e1 = __expf(l[2 + hp] - mx), e2 = __expf(l[4 + hp] - mx), inv = 1.0f / (e0 + e1 + e2);
                al[hp] = e0 * inv; al[2 + hp] = e1 * inv; al[4 + hp] = e2 * inv; } }
            f32x4 v[4][2]; float ssA = 0.f, ssB = 0.f, ssM = 0.f;
#pragma unroll
            for (int j = 0; j < 4; ++j) { const int c = 8 * (lane + 64 * j); unpack8(*(const u32x4*)(row + c), v[j][0], v[j][1]);
                const int seg = c < 768 ? 0 : (c < 1536 ? 1 : 2);
                if (seg == 1) { const int hb = (c - 768) >> 7; float a = al[0];
#pragma unroll
                    for (int i = 1; i < 6; ++i) a = (hb == i) ? al[i] : a;
                    v[j][0] = v[j][0] * a; v[j][1] = v[j][1] * a; }
                const float q = sumsq4(v[j][0]) + sumsq4(v[j][1]);
                ssA += seg == 0 ? q : 0.f; ssB += seg == 1 ? q : 0.f; ssM += seg == 2 ? q : 0.f; }
            const float rA = 1.0f / sqrtf(wave_sum(ssA) * (1.0f / 768.0f) + EPS), rB = 1.0f / sqrtf(wave_sum(ssB) * (1.0f / 768.0f) + EPS), rM = 1.0f / sqrtf(wave_sum(ssM) * (1.0f / 512.0f) + EPS);
#pragma unroll
            for (int j = 0; j < 4; ++j) { const int c = 8 * (lane + 64 * j); const int seg = c < 768 ? 0 : (c < 1536 ? 1 : 2);
                const float* gp = seg == 0 ? g_oa + c : (seg == 1 ? g_ob + (c - 768) : g_om + (c - 1536)); const float r = seg == 0 ? rA : (seg == 1 ? rB : rM);
                const f32x4 g0 = *(const f32x4*)gp, g1 = *(const f32x4*)(gp + 4);
                *(u32x4*)(row + c) = pack8(v[j][0] * r * g0, v[j][1] * r * g1); }
        }
    }
    SEAM(4);

    if (IN(5)) {
        pg8::Gemm g{MIX, WOUT, TOK, DM, DM}; pg8::StaticOrder S; S.init(TOK, DM, G, bid);
        pg8::EpiOut<0, false> E{Y3, DM, nullptr, 0};
        pg8::gemm_phase<pg8::EpiOut<0, false>, pg8::StaticOrder, true, true>(ldsl, g, S, E);
    }
    SEAM(5);

    if (IN(6)) {
        for (int t = gw; t < TOK; t += NGW) {
            const float* xr = XROW(t); const bf16* yr = Y3 + (size_t)t * DM; float* orow = out + (size_t)t * DM;
            f32x4 v[4][2]; float ss = 0.f;
#pragma unroll
            for (int j = 0; j < 4; ++j) { const int c = 8 * (lane + 64 * j); unpack8(*(const u32x4*)(yr + c), v[j][0], v[j][1]); ss += sumsq4(v[j][0]) + sumsq4(v[j][1]); }
            const float r3 = 1.0f / sqrtf(wave_sum(ss) * (1.0f / DM) + EPS); float s1 = 0.f;
#pragma unroll
            for (int j = 0; j < 4; ++j) { const int c = 8 * (lane + 64 * j);
                const f32x4 g0 = *(const f32x4*)(g_postmix + c), g1 = *(const f32x4*)(g_postmix + c + 4), x0 = *(const f32x4*)(xr + c), x1 = *(const f32x4*)(xr + c + 4);
                v[j][0] = x0 + v[j][0] * r3 * g0; v[j][1] = x1 + v[j][1] * r3 * g1;
                *(f32x4*)(orow + c) = v[j][0]; *(f32x4*)(orow + c + 4) = v[j][1]; s1 += sumsq4(v[j][0]) + sumsq4(v[j][1]); }
            const float r1 = 1.0f / sqrtf(wave_sum(s1) * (1.0f / DM) + EPS);
#pragma unroll
            for (int j = 0; j < 4; ++j) { const int c = 8 * (lane + 64 * j); const f32x4 g0 = *(const f32x4*)(g_preffn + c), g1 = *(const f32x4*)(g_preffn + c + 4);
                *(u32x4*)(H2 + (size_t)t * DM + c) = pack8(v[j][0] * r1 * g0, v[j][1] * r1 * g1); }
        }
    }
    SEAM(6);

    if (IN(7)) {
        pg8::Gemm g{H2, WUP, TOK, DFF, DM}; pg8::StaticOrder S; S.init(TOK, DFF, G, bid);
        pg8::EpiOut<2, false> E{U, DFF, nullptr, 0};
        pg8::gemm_phase<pg8::EpiOut<2, false>, pg8::StaticOrder, true, true>(ldsl, g, S, E);
    }
    SEAM(7);

    if (IN(8)) {
        pg8::Gemm g{U, WDOWN, TOK, DM, DFF}; pg8::StaticOrder S; S.init(TOK, DM, G, bid);
        pg8::EpiOut<0, false> E{Y5, DM, nullptr, 0};
        pg8::gemm_phase<pg8::EpiOut<0, false>, pg8::StaticOrder, true, true>(ldsl, g, S, E);
    }
    SEAM(8);

    if (IN(9)) {
        for (int t = gw; t < TOK; t += NGW) {
            const bf16* yr = Y5 + (size_t)t * DM; float* orow = out + (size_t)t * DM;
            f32x4 v[4][2]; float ss = 0.f;
#pragma unroll
            for (int j = 0; j < 4; ++j) { const int c = 8 * (lane + 64 * j); unpack8(*(const u32x4*)(yr + c), v[j][0], v[j][1]); ss += sumsq4(v[j][0]) + sumsq4(v[j][1]); }
            const float r5 = 1.0f / sqrtf(wave_sum(ss) * (1.0f / DM) + EPS);
#pragma unroll
            for (int j = 0; j < 4; ++j) { const int c = 8 * (lane + 64 * j);
                const f32x4 g0 = *(const f32x4*)(g_postffn + c), g1 = *(const f32x4*)(g_postffn + c + 4), x0 = *(const f32x4*)(orow + c), x1 = *(const f32x4*)(orow + c + 4);
                *(f32x4*)(orow + c) = x0 + v[j][0] * r5 * g0; *(f32x4*)(orow + c + 4) = x1 + v[j][1] * r5 * g1; }
        }
    }
#undef IN
#undef SEAM
#undef XROW
}

#ifndef MK_N_LAUNCHES
#define MK_N_LAUNCHES 1
#endif
extern "C" void kernel_launch(void* const* d_in, const int* in_sizes, int n_in, void* d_out, int out_size, void* d_ws, size_t ws_size, hipStream_t stream) {
    static int grid = 0;
    if (grid == 0) {
        if (n_in != 20 || in_sizes[0] != TOK_P * DM || in_sizes[1] != (TOK - TOK_P) * DM || out_size != TOK * DM || ws_size < WS_END) {
            fprintf(stderr, "kernel_launch: shape mismatch: n_in %d in0 %d in1 %d out %d ws %zu (need %zu); nothing launched\n", n_in, n_in > 0 ? in_sizes[0] : -1, n_in > 1 ? in_sizes[1] : -1, out_size, ws_size, (size_t)WS_END);
            grid = -1; return; }
        int dev = 0, cus = 0, per_cu = 0;
        if (hipGetDevice(&dev) != hipSuccess || hipDeviceGetAttribute(&cus, hipDeviceAttributeMultiprocessorCount, dev) != hipSuccess) { fprintf(stderr, "kernel_launch: device query failed\n"); grid = -1; return; }
        if (hipFuncSetAttribute((const void*)mk_fwd, hipFuncAttributeMaxDynamicSharedMemorySize, LDS_BYTES) != hipSuccess) { fprintf(stderr, "kernel_launch: hipFuncSetAttribute failed\n"); grid = -1; return; }
        if (hipOccupancyMaxActiveBlocksPerMultiprocessor(&per_cu, (const void*)mk_fwd, NWAVES * 64, LDS_BYTES) != hipSuccess || per_cu < 1) { fprintf(stderr, "kernel_launch: occupancy query says %d\n", per_cu); per_cu = 1; }
        (void)hipGetLastError();
        grid = cus * per_cu;
    }
    if (grid < 0) return;
    Args a{};
    for (int i = 0; i < 20; ++i) a.in[i] = (const float*)d_in[i];
    a.out = (float*)d_out; a.ws = (unsigned char*)d_ws;
#if MK_N_LAUNCHES == 1
    a.ph_lo = 0; a.ph_hi = N_PHASES;
    void* kargs[] = {&a};
    const hipError_t e = hipLaunchCooperativeKernel((const void*)mk_fwd, dim3(grid), dim3(NWAVES * 64), kargs, LDS_BYTES, stream);
    if (e != hipSuccess) fprintf(stderr, "kernel_launch: cooperative launch failed: %s (grid %d)\n", hipGetErrorString(e), grid);
#else
    for (int p = 0; p < N_PHASES; ++p) { a.ph_lo = p; a.ph_hi = p + 1; hipLaunchKernelGGL(mk_fwd, dim3(grid), dim3(NWAVES * 64), LDS_BYTES, stream, a); }
#endif
}
```

```cpp
#include <hip/hip_runtime.h>
#include <hip/hip_cooperative_groups.h>
#include <cstdio>
#include <cstdint>
namespace cg = cooperative_groups;
#ifndef REP_GEMM
#define REP_GEMM 1
#endif
#ifndef REP_ATTN
#define REP_ATTN 1
#endif
#ifndef REP_ROW
#define REP_ROW 1
#endif
namespace pg8 {
#define PG8_LAS __attribute__((address_space(3)))
typedef unsigned short bf16_t;
typedef short bf16x8 __attribute__((ext_vector_type(8)));
typedef float f32x4 __attribute__((ext_vector_type(4)));
typedef unsigned u32x4 __attribute__((ext_vector_type(4)));
constexpr int BM = 256, BK = 64, HALF = 128, HTB = HALF * BK * 2  , STAGE_BYTES = 8 * HTB, NXCD = 8, WGM = 8;

__host__ __device__ __forceinline__ int lds_byte(int r, int c) { const int st = (r >> 4) * 2 + (c >> 5), rr = r & 15, cc = c & 31, ob = rr * 64 + cc * 2; return st * 1024 + (ob ^ (((ob >> 9) & 1) << 5)); }
__host__ __device__ __forceinline__ void stage_rc(int b, int& R, int& C) { const int st = b / 1024, sb = b % 1024, swz = sb ^ (((sb >> 9) & 1) << 5); R = (st >> 1) * 16 + swz / 64; C = (st & 1) * 32 + (swz % 64) / 2; }
__host__ __device__ __forceinline__ int perm32(int rho) { const int n = rho >> 4, i = rho & 15; return 8 * (i >> 2) + 4 * n + (i & 3); }

struct Unit { int pm, pn; };
struct Gemm { const bf16_t* A; const bf16_t* Bt; int M, N, K; };

struct StaticOrder {
    int nM, nN, nwg, G, c;
    __host__ __device__ void init(int M, int N, int G_, int c_) { nM = M / BM; nN = N / BM; nwg = nM * nN; G = G_; c = c_; }
    __host__ __device__ bool next(int i, Unit& u) const {
#if REP_GEMM > 1
        { const int per = nwg / G; if (i >= per * REP_GEMM) return false; i = i % per; }
#endif
        const long L = (long)i * G + c; if (L >= nwg) return false;
        int wgid = (int)L; { const int q = nwg / NXCD, r = nwg % NXCD, xcd = wgid % NXCD, off = wgid / NXCD; wgid = (xcd < r ? xcd * (q + 1) : r * (q + 1) + (xcd - r) * q) + off; }
        const int nig = WGM * nN, gid = wgid / nig, fm = gid * WGM, gsz = (nM - fm) < WGM ? (nM - fm) : WGM;
        u.pm = fm + ((wgid % nig) % gsz); u.pn = (wgid % nig) / gsz; return true;
    }
    __device__ __forceinline__ void a_ready(const Unit&) const {}
    __device__ __forceinline__ void done(const Unit&) const {}
};

__device__ __forceinline__ unsigned cvt_pk_bf16(float lo, float hi) { unsigned r; asm volatile("v_cvt_pk_bf16_f32 %0, %1, %2" : "=v"(r) : "v"(lo), "v"(hi)); return r; }
typedef float f32x2 __attribute__((ext_vector_type(2)));
template <int ACT, bool MEMSPLIT> struct EpiOut {
    static constexpr bool PERM = true, AFTER_DRAIN = false;
    static constexpr int SPLIT_PM = 160, SPLIT_PN = 16;
    bf16_t* O; int ldc; bf16_t* O2; int ldc2;
    __device__ __forceinline__ void operator()(const f32x4 (&acc)[2][2][4][2], const Unit& u, int wr, int wc, int fr, int fq) const {
        int row0 = u.pm * BM + wr * 64 + fr; int colt = u.pn * BM; bf16_t* base = O; int ld = ldc;
        if (MEMSPLIT) { if (u.pm >= SPLIT_PM) { base = O2; ld = ldc2; row0 -= SPLIT_PM * BM; colt -= SPLIT_PN * BM; } }
        const int col0 = colt + wc * 32 + 8 * fq;
#pragma unroll
        for (int ai = 0; ai < 2; ++ai)
#pragma unroll
            for (int m = 0; m < 4; ++m) { bf16_t* rowp = base + (size_t)(row0 + ai * HALF + m * 16) * ld + col0;
#pragma unroll
                for (int bj = 0; bj < 2; ++bj) { f32x4 v0 = acc[ai][bj][m][0], v1 = acc[ai][bj][m][1];
                    if (ACT == 2) {
#pragma unroll
                        for (int e = 0; e < 4; ++e) { const float a = fmaxf(v0[e], 0.f), b = fmaxf(v1[e], 0.f); v0[e] = a * a; v1[e] = b * b; } }
                    u32x4 w; w.x = cvt_pk_bf16(v0[0], v0[1]); w.y = cvt_pk_bf16(v0[2], v0[3]); w.z = cvt_pk_bf16(v1[0], v1[1]); w.w = cvt_pk_bf16(v1[2], v1[3]);
                    *(u32x4*)(rowp + bj * HALF) = w; } }
    }
};
struct OrderWithMem {
    StaticOrder so; int nextra;
    __host__ __device__ bool next(int i, Unit& u) const {
#if REP_GEMM > 1
        const int per = so.nwg / so.G; if (i < per * REP_GEMM) return so.next(i, u);
        const long L = (long)(i - per * (REP_GEMM - 1)) * so.G + so.c;
#else
        const long L = (long)i * so.G + so.c; if (L < so.nwg) return so.next(i, u);
#endif
        const int e = (int)(L - so.nwg); if (e >= nextra) return false;
        u.pm = 160 + e % 20; u.pn = 16 + e / 20; return true;
    }
    __device__ __forceinline__ void a_ready(const Unit&) const {}
    __device__ __forceinline__ void done(const Unit&) const {}
};

template <class Epi, class Sched, bool ALIGN_EPI = false, bool SP2 = false>
__device__ __forceinline__ void gemm_phase(PG8_LAS unsigned char* lds, const Gemm g, const Sched& S, const Epi& E) {
    const int tid = threadIdx.x, wid = __builtin_amdgcn_readfirstlane(tid >> 6), lane = tid & 63, wr = wid >> 2, wc = wid & 3, fr = lane & 15, fq = lane >> 4;
    const int K = g.K, nt = K / BK;
    unsigned voffA[2], voffB[2];
#pragma unroll
    for (int i = 0; i < 2; ++i) { int R, C; stage_rc(tid * 16 + i * 8192, R, C); const int Rb = Epi::PERM ? ((R & ~31) + perm32(R & 31)) : R;
        voffA[i] = (unsigned)(R * K + C) * 2u; voffB[i] = (unsigned)(Rb * K + C) * 2u; }
    const size_t kstep = (size_t)(BK * 2);
    const size_t hstep = (size_t)HALF * K * 2;
    const size_t tstep = 2 * hstep;
    const unsigned ldsw = (unsigned)wid * 1024u;
    const int aoff = lds_byte(wr * 64 + fr, fq * 8), boff = lds_byte(wc * 32 + fr, fq * 8);
#define PG8_SA(b, h) (((b) * 2 + (h)) * HTB)
#define PG8_SB(b, h) ((4 + (b) * 2 + (h)) * HTB)
#define PG8_STAGE(bufoff, gbase, voff) do { _Pragma("unroll") for (int _i = 0; _i < 2; ++_i) \
        __builtin_amdgcn_global_load_lds((const unsigned*)((const char*)(gbase) + (voff)[_i]), (PG8_LAS unsigned*)(lds + (bufoff) + ldsw + _i * 8192), 16, 0, 0); } while (0)
#define PG8_LDA(dst, b, h) do { _Pragma("unroll") for (int m = 0; m < 4; ++m) _Pragma("unroll") for (int k = 0; k < 2; ++k) dst[m][k] = *(const PG8_LAS bf16x8*)(lds + PG8_SA(b, h) + aoff + m * 2048 + k * 1024); } while (0)
#define PG8_LDB(dst, b, h) do { _Pragma("unroll") for (int n = 0; n < 2; ++n) _Pragma("unroll") for (int k = 0; k < 2; ++k) dst[n][k] = *(const PG8_LAS bf16x8*)(lds + PG8_SB(b, h) + boff + n * 2048 + k * 1024); } while (0)
#define PG8_MMA(ai, bj, At, Bt) do { __builtin_amdgcn_s_setprio(1); _Pragma("unroll") for (int m = 0; m < 4; ++m) _Pragma("unroll") for (int n = 0; n < 2; ++n) _Pragma("unroll") for (int k = 0; k < 2; ++k) \
        acc[ai][bj][m][n] = __builtin_amdgcn_mfma_f32_16x16x32_bf16(Bt[n][k], At[m][k], acc[ai][bj][m][n], 0, 0, 0); __builtin_amdgcn_s_setprio(0); } while (0)
#define PG8_WAIT_V(n) asm volatile("s_waitcnt vmcnt(" #n ")" ::: "memory")
#define PG8_WAIT_L(n) asm volatile("s_waitcnt lgkmcnt(" #n ")" ::: "memory")
#define PG8_BAR __builtin_amdgcn_s_barrier()
#define PG8_SCHED __builtin_amdgcn_sched_barrier(0)
    Unit cur, nxt; int ui = 0;
    if (!S.next(0, cur)) return;
    f32x4 acc[2][2][4][2];
#pragma unroll
    for (int a = 0; a < 2; ++a)
#pragma unroll
        for (int b = 0; b < 2; ++b)
#pragma unroll
            for (int m = 0; m < 4; ++m)
#pragma unroll
                for (int n = 0; n < 2; ++n) acc[a][b][m][n] = (f32x4){0.f, 0.f, 0.f, 0.f};
    bf16x8 At[4][2], B0[2][2], B1[2][2];
    const char* cA = (const char*)g.A + (size_t)cur.pm * tstep; const char* cB = (const char*)g.Bt + (size_t)cur.pn * tstep;
    S.a_ready(cur);
    if constexpr (SP2) {
        PG8_STAGE(PG8_SB(0, 0), cB, voffB); PG8_STAGE(PG8_SB(0, 1), cB + hstep, voffB); PG8_STAGE(PG8_SA(0, 0), cA, voffA); PG8_STAGE(PG8_SA(0, 1), cA + hstep, voffA);
        if (wr == 1) PG8_BAR;
        PG8_WAIT_V(2); PG8_BAR;
        PG8_STAGE(PG8_SB(1, 0), cB + kstep, voffB); PG8_STAGE(PG8_SA(1, 0), cA + kstep, voffA); PG8_STAGE(PG8_SB(1, 1), cB + hstep + kstep, voffB);
        PG8_WAIT_V(6); PG8_BAR;
    } else {
        PG8_STAGE(PG8_SB(0, 0), cB, voffB); PG8_STAGE(PG8_SA(0, 0), cA, voffA); PG8_STAGE(PG8_SB(0, 1), cB + hstep, voffB); PG8_STAGE(PG8_SA(0, 1), cA + hstep, voffA);
        if (wr == 1) PG8_BAR;
        PG8_WAIT_V(4); PG8_BAR;
        PG8_STAGE(PG8_SB(1, 0), cB + kstep, voffB); PG8_STAGE(PG8_SA(1, 0), cA + kstep, voffA); PG8_STAGE(PG8_SB(1, 1), cB + hstep + kstep, voffB);
        PG8_WAIT_V(6); PG8_BAR;
    }
    for (;;) {
        const bool has_next = S.next(ui + 1, nxt);
        const char* nA = has_next ? (const char*)g.A + (size_t)nxt.pm * tstep : cA; const char* nB = has_next ? (const char*)g.Bt + (size_t)nxt.pn * tstep : cB;
        for (int t = 0; t < nt; t += 2) {
            const bool last = (t == nt - 2);
            const char* a1 = cA + (size_t)(t + 1) * kstep;
            const char* a2 = last ? nA : cA + (size_t)(t + 2) * kstep; const char* b2 = last ? nB : cB + (size_t)(t + 2) * kstep;
            const char* a3 = a2 + kstep; const char* b3 = b2 + kstep;
            if (last && has_next) S.a_ready(nxt);
            if constexpr (SP2) {
            PG8_LDB(B0, 0, 0); PG8_LDB(B1, 0, 1); PG8_SCHED; PG8_LDA(At, 0, 0); PG8_STAGE(PG8_SA(1, 1), a1 + hstep, voffA);
            PG8_WAIT_V(8); PG8_WAIT_L(0); PG8_BAR; PG8_MMA(0, 0, At, B0); PG8_MMA(0, 1, At, B1); PG8_BAR; PG8_SCHED;
            PG8_LDA(At, 0, 1); PG8_STAGE(PG8_SB(0, 0), b2, voffB); PG8_STAGE(PG8_SB(0, 1), b2 + hstep, voffB); PG8_STAGE(PG8_SA(0, 0), a2, voffA);
            PG8_WAIT_V(8); PG8_WAIT_L(0); PG8_BAR; PG8_MMA(1, 0, At, B0); PG8_MMA(1, 1, At, B1); PG8_BAR; PG8_SCHED;
            PG8_LDB(B0, 1, 0); PG8_LDB(B1, 1, 1); PG8_SCHED; PG8_LDA(At, 1, 0); PG8_STAGE(PG8_SA(0, 1), a2 + hstep, voffA);
            PG8_WAIT_V(8); PG8_WAIT_L(0); PG8_BAR; PG8_MMA(0, 0, At, B0); PG8_MMA(0, 1, At, B1); PG8_BAR; PG8_SCHED;
            PG8_LDA(At, 1, 1); PG8_STAGE(PG8_SB(1, 0), b3, voffB); PG8_STAGE(PG8_SB(1, 1), b3 + hstep, voffB); PG8_STAGE(PG8_SA(1, 0), a3, voffA);
            PG8_WAIT_V(8); PG8_WAIT_L(0); PG8_BAR; PG8_MMA(1, 0, At, B0); PG8_MMA(1, 1, At, B1); PG8_BAR; PG8_SCHED;
            } else {
            PG8_LDB(B0, 0, 0); PG8_SCHED; PG8_LDA(At, 0, 0); PG8_STAGE(PG8_SA(1, 1), a1 + hstep, voffA);
            PG8_WAIT_L(8); PG8_BAR; PG8_WAIT_L(0); PG8_MMA(0, 0, At, B0); PG8_BAR; PG8_SCHED;
            PG8_LDB(B1, 0, 1); PG8_STAGE(PG8_SB(0, 0), b2, voffB);
            PG8_BAR; PG8_WAIT_L(0); PG8_MMA(0, 1, At, B1); PG8_BAR;
            PG8_LDA(At, 0, 1); PG8_STAGE(PG8_SA(0, 0), a2, voffA);
            PG8_BAR; PG8_WAIT_L(0); PG8_MMA(1, 0, At, B0); PG8_BAR; PG8_SCHED;
            PG8_STAGE(PG8_SB(0, 1), b2 + hstep, voffB);
            PG8_WAIT_V(6); PG8_BAR; PG8_MMA(1, 1, At, B1); PG8_BAR;
            PG8_LDB(B0, 1, 0); PG8_SCHED; PG8_LDA(At, 1, 0); PG8_STAGE(PG8_SA(0, 1), a2 + hstep, voffA);
            PG8_WAIT_L(8); PG8_BAR; PG8_WAIT_L(0); PG8_MMA(0, 0, At, B0); PG8_BAR; PG8_SCHED;
            PG8_LDB(B1, 1, 1); PG8_STAGE(PG8_SB(1, 0), b3, voffB);
            PG8_BAR; PG8_WAIT_L(0); PG8_MMA(0, 1, At, B1); PG8_BAR;
            PG8_LDA(At, 1, 1); PG8_STAGE(PG8_SA(1, 0), a3, voffA);
            PG8_BAR; PG8_WAIT_L(0); PG8_MMA(1, 0, At, B0); PG8_BAR; PG8_SCHED;
            PG8_STAGE(PG8_SB(1, 1), b3 + hstep, voffB);
            PG8_WAIT_V(6); PG8_BAR; PG8_MMA(1, 1, At, B1); PG8_BAR;
            }
        }
        if constexpr (ALIGN_EPI) { if (wr == 0) PG8_BAR; }
        if constexpr (!Epi::AFTER_DRAIN) { E(acc, cur, wr, wc, fr, fq); S.done(cur); }
        if (!has_next) break;
#pragma unroll
        for (int a = 0; a < 2; ++a)
#pragma unroll
            for (int b = 0; b < 2; ++b)
#pragma unroll
                for (int m = 0; m < 4; ++m)
#pragma unroll
                    for (int n = 0; n < 2; ++n) acc[a][b][m][n] = (f32x4){0.f, 0.f, 0.f, 0.f};
        cur = nxt; cA = nA; cB = nB; ++ui;
        if constexpr (ALIGN_EPI) { if (wr == 1) PG8_BAR; }
    }
    PG8_WAIT_V(0);
    if constexpr (!ALIGN_EPI) { if (wr == 0) PG8_BAR; }
    PG8_BAR;
    if constexpr (Epi::AFTER_DRAIN) { E.fused(acc, cur, wr, wc, fr, fq, lds, wid, lane); S.done(cur); }
#undef PG8_SA
#undef PG8_SB
#undef PG8_STAGE
#undef PG8_LDA
#undef PG8_LDB
#undef PG8_MMA
#undef PG8_WAIT_V
#undef PG8_WAIT_L
#undef PG8_BAR
#undef PG8_SCHED
}
}
namespace att {
using bf16 = unsigned short;
constexpr int   D = 128, NW = 8, QBLK = 32, KVBLK = 64;
constexpr float SCALE = 0.088388347648318440f;
constexpr float THR = 8.f;
constexpr float MINIT = -30000.f;
constexpr size_t SHM_V = KVBLK * D * 2, SHM_K = KVBLK * D * 2;
constexpr size_t SHM_ATTN = 2 * SHM_V + 2 * SHM_K + NW * 64 * 4 + 1024;
using bf16x8 = __attribute__((ext_vector_type(8))) short;
using s16x4  = __attribute__((ext_vector_type(4))) short;
using f32x16 = __attribute__((ext_vector_type(16))) float;
using u32x4  = __attribute__((ext_vector_type(4))) unsigned;
#define KSWZ(row, colB) ((row) * 256 + ((colB) ^ (((row) & 7) << 4)))
#define SBAR() __builtin_amdgcn_sched_barrier(0)
__device__ __forceinline__ int crow(int r, int hi) { return (r & 3) + 8 * (r >> 2) + 4 * hi; }
__device__ __forceinline__ unsigned cvtpk(float lo, float hi) {
  unsigned r; asm volatile("v_cvt_pk_bf16_f32 %0, %1, %2" : "=v"(r) : "v"(lo), "v"(hi)); return r;
}
__device__ __forceinline__ void partialSM(f32x16& p0, f32x16& p1, float& m_reg, float& mn, float& alpha) {
  constexpr float C = SCALE * 1.4426950408889634f;
  float pmax = p0[0]; for (int r = 1; r < 16; ++r) pmax = fmaxf(pmax, p0[r]); for (int r = 0; r < 16; ++r) pmax = fmaxf(pmax, p1[r]);
  { auto rr = __builtin_amdgcn_permlane32_swap(__float_as_uint(pmax), __float_as_uint(pmax), false, false);
    pmax = fmaxf(__uint_as_float(rr[0]), __uint_as_float(rr[1])); }
  if (__builtin_expect(__all(pmax - m_reg <= THR / SCALE), 1)) { mn = m_reg; alpha = 1.f; }
  else { mn = fmaxf(m_reg, pmax); alpha = __builtin_amdgcn_exp2f((m_reg - mn) * C); m_reg = mn; }
  float mnC = -mn * C;
  for (int r = 0; r < 16; ++r) p0[r] = fmaf(p0[r], C, mnC); for (int r = 0; r < 16; ++r) p1[r] = fmaf(p1[r], C, mnC);
  for (int r = 0; r < 16; ++r) p0[r] = __builtin_amdgcn_exp2f(p0[r]);
}
__device__ __forceinline__ void finishSM(f32x16& p0, f32x16& p1, float alpha, float& l_reg, bf16x8& pa0, bf16x8& pa1, bf16x8& pa2, bf16x8& pa3) {
  for (int r = 0; r < 16; ++r) p1[r] = __builtin_amdgcn_exp2f(p1[r]);
  float ps = 0; for (int r = 0; r < 16; ++r) ps += p0[r]; for (int r = 0; r < 16; ++r) ps += p1[r];
  { auto rr = __builtin_amdgcn_permlane32_swap(__float_as_uint(ps), __float_as_uint(ps), false, false);
    ps = __uint_as_float(rr[0]) + __uint_as_float(rr[1]); }
  l_reg = l_reg * alpha + ps;
#define PK4(P, BASE, OUT) do { unsigned a0 = cvtpk(P[BASE + 0], P[BASE + 1]), a1 = cvtpk(P[BASE + 2], P[BASE + 3]);   \
    unsigned b0 = cvtpk(P[BASE + 4], P[BASE + 5]), b1 = cvtpk(P[BASE + 6], P[BASE + 7]);                              \
    auto r0 = __builtin_amdgcn_permlane32_swap(a0, b0, false, false); auto r1 = __builtin_amdgcn_permlane32_swap(a1, b1, false, false); \
    u32x4 w = {r0[0], r1[0], r0[1], r1[1]}; OUT = *reinterpret_cast<bf16x8*>(&w); } while (0)
  PK4(p0, 0, pa0); PK4(p0, 8, pa1); PK4(p1, 0, pa2); PK4(p1, 8, pa3);
#undef PK4
}
__device__ __forceinline__ void qkt(f32x16& p0, f32x16& p1, const bf16* Ks, const bf16x8* qr, int r32, int hi) {
  p0 = f32x16{}; p1 = f32x16{};
  for (int d0 = 0; d0 < 8; ++d0) { int cb = (d0 * 16 + hi * 8) * 2;
    bf16x8 b0 = *reinterpret_cast<const bf16x8*>((const char*)Ks + KSWZ(r32, cb));
    bf16x8 b1 = *reinterpret_cast<const bf16x8*>((const char*)Ks + KSWZ(32 + r32, cb));
    p0 = __builtin_amdgcn_mfma_f32_32x32x16_bf16(b0, qr[d0], p0, 0, 0, 0);
    p1 = __builtin_amdgcn_mfma_f32_32x32x16_bf16(b1, qr[d0], p1, 0, 0, 0); }
}
__device__ __forceinline__ int v_st(int k, int c) { const int kk = (k & ~0xC) | ((k & 4) << 1) | ((k & 8) >> 1); return ((kk >> 3) * 4 + (c >> 5)) * 512 + ((kk & 7) * 32 + (c & 31)) * 2; }
__device__ __forceinline__ int v_rd_base(int lane) { return ((lane & 3) << 3) | (((lane >> 2) & 3) << 6) | (((lane >> 4) & 1) << 5) | (((lane >> 5) & 1) << 8); }
constexpr int v_rd_off(int d0, int ks, int half) { return d0 * 512 + ks * 4096 + half * 2048; }
template <int OFF> __device__ __forceinline__ s16x4 tr_read(int vb) {
  s16x4 r; asm volatile("ds_read_b64_tr_b16 %0, %1 offset:%2" : "=&v"(r) : "v"(vb), "i"(OFF) : "memory"); return r;
}
template <int D0> __device__ __forceinline__ void pv_one(f32x16& od, int vb, bf16x8 pa0, bf16x8 pa1, bf16x8 pa2, bf16x8 pa3) {
  const s16x4 l0 = tr_read<v_rd_off(D0, 0, 0)>(vb), h0 = tr_read<v_rd_off(D0, 0, 1)>(vb), l1 = tr_read<v_rd_off(D0, 1, 0)>(vb), h1 = tr_read<v_rd_off(D0, 1, 1)>(vb);
  const s16x4 l2 = tr_read<v_rd_off(D0, 2, 0)>(vb), h2 = tr_read<v_rd_off(D0, 2, 1)>(vb), l3 = tr_read<v_rd_off(D0, 3, 0)>(vb), h3 = tr_read<v_rd_off(D0, 3, 1)>(vb);
  asm volatile("s_waitcnt lgkmcnt(0)" ::: "memory"); SBAR();
#define PK(L, H) (bf16x8){L[0], L[1], L[2], L[3], H[0], H[1], H[2], H[3]}
  od = __builtin_amdgcn_mfma_f32_32x32x16_bf16(pa0, PK(l0, h0), od, 0, 0, 0);
  od = __builtin_amdgcn_mfma_f32_32x32x16_bf16(pa1, PK(l1, h1), od, 0, 0, 0);
  od = __builtin_amdgcn_mfma_f32_32x32x16_bf16(pa2, PK(l2, h2), od, 0, 0, 0);
  od = __builtin_amdgcn_mfma_f32_32x32x16_bf16(pa3, PK(l3, h3), od, 0, 0, 0);
#undef PK
}
__device__ __forceinline__ void pv_d0(f32x16* o, int vb, bf16x8 pa0, bf16x8 pa1, bf16x8 pa2, bf16x8 pa3) {
  pv_one<0>(o[0], vb, pa0, pa1, pa2, pa3); pv_one<1>(o[1], vb, pa0, pa1, pa2, pa3); pv_one<2>(o[2], vb, pa0, pa1, pa2, pa3); pv_one<3>(o[3], vb, pa0, pa1, pa2, pa3);
}
__device__ __forceinline__ void band_mask(f32x16& p0, f32x16& p1, int base, int hi, const float* biasL) {
#pragma unroll
  for (int r = 0; r < 16; ++r) {
    const int k0 = base + crow(r, hi), k1 = k0 + 32;
    const int c0 = min(max(k0, 0), 128), c1 = min(max(k1, 0), 128);
    const float b0 = biasL[c0], b1 = biasL[c1];
    p0[r] = ((unsigned)k0 <= 128u) ? p0[r] + b0 : MINIT;
    p1[r] = ((unsigned)k1 <= 128u) ? p1[r] + b1 : MINIT;
  }
}
__device__ __forceinline__ unsigned short f2bf(float f) { unsigned u = __builtin_bit_cast(unsigned, f); return (unsigned short)((u + 0x7fffu + ((u >> 16) & 1u)) >> 16); }

template <int MODE>
__device__ __forceinline__ void attn_unit(const bf16* __restrict__ Qh, const bf16* __restrict__ Kh, const bf16* __restrict__ Vh, bf16* __restrict__ Oh,
                                          float* __restrict__ lse_o, const int ldk, const int NT, const int dil, const int two, const int m0, const int ms,
                                          const float* __restrict__ bias_g, char* lds) {
  constexpr int LDQ = 4096, LDO = 2048;
  const int tid = threadIdx.x, wid = tid >> 6, lane = tid & 63, r32 = lane & 31, hi = lane >> 5;
  bf16* V_lds = (bf16*)lds; bf16* K_lds = (bf16*)(lds + 2 * SHM_V);
  float* ws = (float*)(lds + 2 * SHM_V + 2 * SHM_K) + wid * 64; float* li_l = ws; float* al_l = ws + 32;
  float* biasL = (float*)(lds + 2 * SHM_V + 2 * SHM_K + NW * 64 * 4);
  float m_reg = MINIT, l_reg = 0; f32x16 o[4] = {}; bf16x8 qr[8];
  const int qi = wid * QBLK + r32;
  int qt = qi, qpos = 0;
  if (MODE == 1) { qt = two ? ((qi & 127) * dil + (qi >> 7)) : qi * dil; qpos = two ? ((qi & 127) + 4096 * (qi >> 7)) : (m0 + qi); }
  const bf16* Qw = Qh + (long)qt * LDQ + hi * 8;
#pragma unroll
  for (int d0 = 0; d0 < 8; ++d0) qr[d0] = *reinterpret_cast<const bf16x8*>(Qw + d0 * 16);
  if (MODE == 1) {
    if (tid < 129) {
      const int rel = (tid - 64) * dil, n = rel < 0 ? -rel : rel; const float nf = (float)(n > 1 ? n : 1);
      int large = 8 + (int)(logf(nf * 0.125f) / 4.852030263919617f * 8.0f); large = large < 15 ? large : 15;
      const int bucket = (rel > 0 ? 16 : 0) + (n < 8 ? n : large);
      biasL[tid] = bias_g[bucket * 6] * (1.0f / SCALE);
    }
  }
  const int rs = (MODE == 1) ? dil : 1;
  const int sr = tid >> 4, sc = (tid & 15) * 8, vst0 = v_st(sr, sc), vst1 = v_st(32 + sr, sc);
  const int vb0 = (int)(uintptr_t)V_lds + v_rd_base(lane);
  const unsigned lo0 = (unsigned)(sr * rs * ldk + sc), lo1 = lo0 + (unsigned)(32 * rs * ldk);
  constexpr int SDEPTH = (MODE == 1) ? 1 : 2;
  struct { bf16x8 vs0, vs1, ks0, ks1; } sr_[SDEPTH];
#define KTOK0(j) ((MODE == 0) ? 64 * (j) : (two ? ((64 * ((j) & 1)) * dil + ((j) >> 1)) : (ms + 64 * (j)) * dil))
#define KPOS0(j) (two ? (64 * ((j) & 1) + 4096 * ((j) >> 1)) : (ms + 64 * (j)))
#define SLOAD(i, j) do { const long tb_ = (long)__builtin_amdgcn_readfirstlane(KTOK0(j)) * ldk; const bf16* kt_ = Kh + tb_; const bf16* vt_ = Vh + tb_; \
    sr_[i].vs0 = *reinterpret_cast<const bf16x8*>(vt_ + lo0); sr_[i].vs1 = *reinterpret_cast<const bf16x8*>(vt_ + lo1); \
    sr_[i].ks0 = *reinterpret_cast<const bf16x8*>(kt_ + lo0); sr_[i].ks1 = *reinterpret_cast<const bf16x8*>(kt_ + lo1); } while (0)
#define SWRITE(b, i) do { *(bf16x8*)((char*)V_lds + (b) * SHM_V + vst0) = sr_[i].vs0;          \
    *(bf16x8*)((char*)V_lds + (b) * SHM_V + vst1) = sr_[i].vs1; int kc = sc * 2;               \
    *(bf16x8*)((char*)K_lds + (b) * SHM_K + KSWZ(sr, kc)) = sr_[i].ks0;                       \
    *(bf16x8*)((char*)K_lds + (b) * SHM_K + KSWZ(32 + sr, kc)) = sr_[i].ks1; } while (0)
#define SWAIT() do { if constexpr (SDEPTH == 2) asm volatile("s_waitcnt vmcnt(4)" ::: "memory"); else asm volatile("s_waitcnt vmcnt(0)" ::: "memory"); } while (0)
#define RESC(a) do { if (__any((a) < 1.f)) { if (hi == 0) al_l[r32] = (a); asm volatile("s_waitcnt lgkmcnt(0)" ::: "memory"); \
    for (int d = 0; d < 4; ++d) for (int r = 0; r < 16; ++r) o[d][r] *= al_l[crow(r, hi)]; } } while (0)
#define MASK(P0, P1, j) do { if (MODE == 1) band_mask(P0, P1, KPOS0(j) - qpos + 64, hi, biasL); } while (0)
  f32x16 pA0, pA1, pB0, pB1; float mnA, mnB, alA, alB; bf16x8 pa0, pa1, pa2, pa3;
  constexpr int SE = 0, SO = SDEPTH - 1;
  SLOAD(SE, 0); asm volatile("s_waitcnt vmcnt(0)" ::: "memory"); SWRITE(0, SE); __syncthreads();
  qkt(pA0, pA1, K_lds, qr, r32, hi); MASK(pA0, pA1, 0); partialSM(pA0, pA1, m_reg, mnA, alA);
  SLOAD(SO, 1); if constexpr (SDEPTH == 2) { if (2 < NT) SLOAD(SE, 2); }
  SWAIT(); SWRITE(1, SO); __syncthreads();
  for (int j = 1; j + 1 < NT; j += 2) {
    SBAR(); qkt(pB0, pB1, (bf16*)((char*)K_lds + SHM_K), qr, r32, hi);
    finishSM(pA0, pA1, alA, l_reg, pa0, pa1, pa2, pa3); SBAR();
    SLOAD(SO, j + SDEPTH); SBAR();
    pv_d0(o, vb0, pa0, pa1, pa2, pa3); MASK(pB0, pB1, j); partialSM(pB0, pB1, m_reg, mnB, alB);
    __syncthreads(); SWAIT(); SWRITE(0, SE);
    RESC(alB); __syncthreads();
    SBAR(); qkt(pA0, pA1, K_lds, qr, r32, hi);
    finishSM(pB0, pB1, alB, l_reg, pa0, pa1, pa2, pa3); SBAR();
    if (SDEPTH == 1 || j + 3 < NT) SLOAD(SE, j + 1 + SDEPTH); SBAR();
    pv_d0(o, vb0 + (int)SHM_V, pa0, pa1, pa2, pa3); MASK(pA0, pA1, j + 1); partialSM(pA0, pA1, m_reg, mnA, alA);
    __syncthreads(); SWAIT(); SWRITE(1, SO);
    RESC(alA); __syncthreads();
  }
  SBAR(); qkt(pB0, pB1, (bf16*)((char*)K_lds + SHM_K), qr, r32, hi);
  finishSM(pA0, pA1, alA, l_reg, pa0, pa1, pa2, pa3); SBAR();
  pv_d0(o, vb0, pa0, pa1, pa2, pa3); MASK(pB0, pB1, NT - 1); partialSM(pB0, pB1, m_reg, mnB, alB);
  __syncthreads(); RESC(alB);
  finishSM(pB0, pB1, alB, l_reg, pa0, pa1, pa2, pa3); SBAR();
  pv_d0(o, vb0 + (int)SHM_V, pa0, pa1, pa2, pa3);
  if (hi == 0) li_l[r32] = l_reg; asm volatile("s_waitcnt lgkmcnt(0)" ::: "memory");
  float rli[16];
#pragma unroll
  for (int r = 0; r < 16; ++r) rli[r] = __builtin_amdgcn_rcpf(li_l[crow(r, hi)]);
#pragma unroll
  for (int r = 0; r < 16; ++r) { const int qo = wid * QBLK + crow(r, hi);
    long ot = qo; if (MODE == 1) ot = two ? ((qo & 127) * dil + (qo >> 7)) : qo * dil;
    bf16* Ow = Oh + ot * LDO + r32;
#pragma unroll
    for (int d0 = 0; d0 < 4; ++d0) Ow[d0 * 32] = f2bf(o[d0][r] * rli[r]); }
  if (MODE == 1) { if (hi == 0) lse_o[(long)qt * 6] = m_reg * SCALE + logf(l_reg); }
#undef KTOK0
#undef KPOS0
#undef SLOAD
#undef SWRITE
#undef SWAIT
#undef RESC
#undef MASK
}

__device__ __forceinline__ void attn_unit_band(const bf16* __restrict__ Qh, const bf16* __restrict__ Kh, const bf16* __restrict__ Vh, bf16* __restrict__ Oh,
                                               float* __restrict__ lse_o, const int ldk, const int NT, const int dil, const int two, const int m0, const int ms,
                                               const float* __restrict__ bias_g, char* lds) {
  constexpr int LDQ = 4096, LDO = 2048;
  const int tid = threadIdx.x, wid = tid >> 6, lane = tid & 63, r32 = lane & 31, hi = lane >> 5;
  bf16* V_lds = (bf16*)lds; bf16* K_lds = (bf16*)(lds + 2 * SHM_V);
  float* ws = (float*)(lds + 2 * SHM_V + 2 * SHM_K) + wid * 64; float* li_l = ws; float* al_l = ws + 32;
  float* biasL = (float*)(lds + 2 * SHM_V + 2 * SHM_K + NW * 64 * 4);
  float m_reg = MINIT, l_reg = 0; f32x16 o[4] = {}; bf16x8 qr[8];
  const int qi = wid * QBLK + r32;
  const int qt = two ? ((qi & 127) * dil + (qi >> 7)) : qi * dil, qpos = two ? ((qi & 127) + 4096 * (qi >> 7)) : (m0 + qi);
  const bf16* Qw = Qh + (long)qt * LDQ + hi * 8;
#pragma unroll
  for (int d0 = 0; d0 < 8; ++d0) qr[d0] = *reinterpret_cast<const bf16x8*>(Qw + d0 * 16);
  if (tid < 129) {
    const int rel = (tid - 64) * dil, n = rel < 0 ? -rel : rel; const float nf = (float)(n > 1 ? n : 1);
    int large = 8 + (int)(logf(nf * 0.125f) / 4.852030263919617f * 8.0f); large = large < 15 ? large : 15;
    const int bucket = (rel > 0 ? 16 : 0) + (n < 8 ? n : large);
    biasL[tid] = bias_g[bucket * 6] * (1.0f / SCALE);
  }
  const int sr = tid >> 4, sc = (tid & 15) * 8, vst0 = v_st(sr, sc), vst1 = v_st(32 + sr, sc);
  const int vb0 = (int)(uintptr_t)V_lds + v_rd_base(lane);
  const unsigned lo0 = (unsigned)(sr * dil * ldk + sc), lo1 = lo0 + (unsigned)(32 * dil * ldk);
  bf16x8 vs0, vs1, ks0, ks1;
#define KTOK0(j) (two ? ((64 * ((j) & 1)) * dil + ((j) >> 1)) : (ms + 64 * (j)) * dil)
#define KPOS0(j) (two ? (64 * ((j) & 1) + 4096 * ((j) >> 1)) : (ms + 64 * (j)))
#define SLOAD(j) do { const long tb_ = (long)__builtin_amdgcn_readfirstlane(KTOK0(j)) * ldk; const bf16* kt_ = Kh + tb_; const bf16* vt_ = Vh + tb_; \
    vs0 = *reinterpret_cast<const bf16x8*>(vt_ + lo0); vs1 = *reinterpret_cast<const bf16x8*>(vt_ + lo1); \
    ks0 = *reinterpret_cast<const bf16x8*>(kt_ + lo0); ks1 = *reinterpret_cast<const bf16x8*>(kt_ + lo1); } while (0)
  SLOAD(0);
  for (int j = 0; j < NT; ++j) {
    asm volatile("s_waitcnt vmcnt(0)" ::: "memory");
    __syncthreads();
    *(bf16x8*)((char*)V_lds + vst0) = vs0; *(bf16x8*)((char*)V_lds + vst1) = vs1;
    *(bf16x8*)((char*)K_lds + KSWZ(sr, sc * 2)) = ks0; *(bf16x8*)((char*)K_lds + KSWZ(32 + sr, sc * 2)) = ks1;
    __syncthreads();
    if (j + 1 < NT) SLOAD(j + 1);
    f32x16 p0, p1; float mn, al; bf16x8 pa0, pa1, pa2, pa3;
    SBAR(); qkt(p0, p1, K_lds, qr, r32, hi);
    band_mask(p0, p1, KPOS0(j) - qpos + 64, hi, biasL);
    partialSM(p0, p1, m_reg, mn, al);
    if (__any(al < 1.f)) { if (hi == 0) al_l[r32] = al; asm volatile("s_waitcnt lgkmcnt(0)" ::: "memory");
#pragma unroll
      for (int d = 0; d < 4; ++d)
#pragma unroll
        for (int r = 0; r < 16; ++r) o[d][r] *= al_l[crow(r, hi)]; }
    finishSM(p0, p1, al, l_reg, pa0, pa1, pa2, pa3); SBAR();
    pv_d0(o, vb0, pa0, pa1, pa2, pa3);
  }
  if (hi == 0) li_l[r32] = l_reg; asm volatile("s_waitcnt lgkmcnt(0)" ::: "memory");
  float rli[16];
#pragma unroll
  for (int r = 0; r < 16; ++r) rli[r] = __builtin_amdgcn_rcpf(li_l[crow(r, hi)]);
#pragma unroll
  for (int r = 0; r < 16; ++r) { const int qo = wid * QBLK + crow(r, hi);
    const long ot = two ? ((qo & 127) * dil + (qo >> 7)) : qo * dil;
    bf16* Ow = Oh + ot * LDO + r32;
#pragma unroll
    for (int d0 = 0; d0 < 4; ++d0) Ow[d0 * 32] = f2bf(o[d0][r] * rli[r]); }
  if (hi == 0) lse_o[(long)qt * 6] = m_reg * SCALE + logf(l_reg);
#undef KTOK0
#undef KPOS0
#undef SLOAD
}
#undef KSWZ
#undef SBAR
}
#define LAS __attribute__((address_space(3)))
#define XB_TMO      128
#define XB_XCNT(j)  (256  + 64 * (j))
#define XB_XSUB(j)  (1280 + 64 * (j))
#define XB_XGEN(j)  (2304 + 64 * (j))
#define XB_TOP      3328
#define XB_TOPGEN   3392
#define XCD_BAR_WORDS 3456
#define XB_SPIN_CAP (1u << 18)

__device__ __forceinline__ unsigned xb_ld(unsigned* p)              { return __hip_atomic_load(p, __ATOMIC_RELAXED, __HIP_MEMORY_SCOPE_AGENT); }
__device__ __forceinline__ unsigned xb_add(unsigned* p, unsigned v) { return __hip_atomic_fetch_add(p, v, __ATOMIC_RELAXED, __HIP_MEMORY_SCOPE_AGENT); }
__device__ __forceinline__ unsigned xb_xcc_id() { return (unsigned)__builtin_amdgcn_s_getreg((3 << 11) | 20) & 0xFu; }
#define XB_SPIN(cond, bar) do { unsigned _sp = 0; while (cond) { __builtin_amdgcn_s_sleep(1); \
    if ((++_sp & 255u) == 0u) { if (xb_ld(&(bar)[XB_TMO])) break; if (_sp > XB_SPIN_CAP) { atomicAdd(&(bar)[XB_TMO], 1u); break; } } } } while (0)

struct XcdBarrier {
    unsigned* bar; unsigned x;
    volatile LAS unsigned* st;
};

__device__ __forceinline__ XcdBarrier xcd_barrier_post(unsigned* bar, volatile LAS unsigned* st) {
    XcdBarrier b; b.bar = bar; b.x = xb_xcc_id(); b.st = st;
    if (threadIdx.x == 0) (void)xb_add(&bar[XB_XCNT(b.x)], 1u);
    return b;
}
__device__ __forceinline__ void xcd_barrier_complete(unsigned* bar, unsigned x, unsigned& nloc, unsigned& nx) {
    const unsigned G = gridDim.x * gridDim.y * gridDim.z;
    unsigned sum, cnt, mine, sp = 0u;
    for (;;) {
        sum = 0u; cnt = 0u; mine = 0u;
#pragma unroll
        for (unsigned j = 0; j < 16; ++j) { const unsigned c = xb_ld(&bar[XB_XCNT(j)]); sum += c; cnt += (c > 0u) ? 1u : 0u; mine = (j == x) ? c : mine; }
        if (sum == G) break;
        __builtin_amdgcn_s_sleep(1);
        if ((++sp & 255u) == 0u) { if (xb_ld(&bar[XB_TMO])) break; if (sp > XB_SPIN_CAP) { atomicAdd(&bar[XB_TMO], 1u); break; } }
    }
    nloc = mine > 0u ? mine : 1u; nx = cnt > 0u ? cnt : 1u;
}

__device__ __forceinline__ void xcd_barrier(const XcdBarrier& b) {
    asm volatile("s_waitcnt vmcnt(0)" ::: "memory");
    __syncthreads();
    if (threadIdx.x == 0) {
        unsigned* bar = b.bar;
        __builtin_amdgcn_s_waitcnt(0);
        unsigned nloc = b.st[0], nx = b.st[1];
        if (nloc == 0u) { xcd_barrier_complete(bar, b.x, nloc, nx); b.st[0] = nloc; b.st[1] = nx; }
        const unsigned old = xb_add(&bar[XB_XSUB(b.x)], 1u);
        const unsigned gen = old / nloc;
        if (old + 1u == (gen + 1u) * nloc) {
            __builtin_amdgcn_fence(__ATOMIC_RELEASE, "agent");
            asm volatile("s_waitcnt vmcnt(0)" ::: "memory");
            const unsigned og = xb_add(&bar[XB_TOP], 1u);
            const unsigned tg = og / nx;
            if (og + 1u == (tg + 1u) * nx) xb_add(&bar[XB_TOPGEN], 1u);
            else XB_SPIN(xb_ld(&bar[XB_TOPGEN]) == tg, bar);
            __builtin_amdgcn_fence(__ATOMIC_ACQUIRE, "agent");
            xb_add(&bar[XB_XGEN(b.x)], 1u);
            asm volatile("s_waitcnt vmcnt(0)" ::: "memory");
        } else {
            XB_SPIN(xb_ld(&bar[XB_XGEN(b.x)]) == gen, bar);
            __builtin_amdgcn_fence(__ATOMIC_ACQUIRE, "agent");
            asm volatile("s_waitcnt vmcnt(0)" ::: "memory");
        }
    }
    __syncthreads();
}
typedef unsigned short bf16;
typedef float f32x4 __attribute__((ext_vector_type(4)));
typedef unsigned u32x4 __attribute__((ext_vector_type(4)));
typedef float f32x2 __attribute__((ext_vector_type(2)));

constexpr int NWAVES = 8;
constexpr int DM = 2048, SEQ = 2048, NB_P = 4, NB_S = 16, NBATCH = NB_P + NB_S;
constexpr int TOK_P = NB_P * SEQ, TOK = NBATCH * SEQ;
constexpr int NMEM = 256, MEMROWS = NBATCH * NMEM;
constexpr int INC = 4096, DFF = 8192, MEMKV = 1024;
constexpr int C_QA = 0, C_KA = 768, C_VA = 1024, C_QB = 1280, C_KB = 2048, C_VB = 2816, C_QM = 3584;
constexpr float EPS = 1e-6f;

constexpr size_t MiB = 1u << 20;
constexpr size_t WS_ROPE = 1 * MiB;
constexpr size_t WS_WIN = 2 * MiB, WS_WMEM = 18 * MiB;
constexpr size_t WS_WOUT = 22 * MiB, WS_WUP = 30 * MiB, WS_WDOWN = 62 * MiB;
constexpr size_t WS_LSE = 94 * MiB;
constexpr size_t WS_KVM = 96 * MiB;
constexpr size_t WS_H = 112 * MiB, WS_MEMN = 272 * MiB;
constexpr size_t WS_U = 296 * MiB;
constexpr size_t WS_END = WS_U + (size_t)TOK * DFF * 2;
static_assert(WS_WMEM == WS_WIN + (size_t)INC * DM * 2 && WS_MEMN == WS_H + (size_t)TOK * DM * 2, "contiguous operands");
static_assert(WS_LSE + (size_t)TOK * 6 * 4 <= WS_KVM && WS_KVM + (size_t)MEMROWS * MEMKV * 2 <= WS_H && WS_MEMN + (size_t)MEMROWS * DM * 2 <= WS_U, "ws map");

constexpr int RING_BYTES = 131072;
constexpr int LDS_BYTES = 147456;
static_assert(att::SHM_ATTN <= RING_BYTES && pg8::STAGE_BYTES <= RING_BYTES, "LDS map");

__device__ __forceinline__ float wave_sum(float v) {
#pragma unroll
    for (int o = 1; o < 64; o <<= 1) v += __shfl_xor(v, o);
    return v;
}
__device__ __forceinline__ unsigned f2bf(float f) { unsigned u = __builtin_bit_cast(unsigned, f); return (u + 0x7fffu + ((u >> 16) & 1u)) >> 16; }
__device__ __forceinline__ unsigned pk2(float lo, float hi) { return f2bf(lo) | (f2bf(hi) << 16); }
__device__ __forceinline__ float bflo(unsigned w) { return __uint_as_float(w << 16); }
__device__ __forceinline__ float bfhi(unsigned w) { return __uint_as_float(w & 0xffff0000u); }
__device__ __forceinline__ u32x4 pack8(const f32x4 a, const f32x4 b) { u32x4 o; o.x = pk2(a.x, a.y); o.y = pk2(a.z, a.w); o.z = pk2(b.x, b.y); o.w = pk2(b.z, b.w); return o; }
__device__ __forceinline__ void unpack8(const u32x4 w, f32x4& a, f32x4& b) { a = (f32x4){bflo(w.x), bfhi(w.x), bflo(w.y), bfhi(w.y)}; b = (f32x4){bflo(w.z), bfhi(w.z), bflo(w.w), bfhi(w.w)}; }
__device__ __forceinline__ float sumsq4(const f32x4 a) { return (a.x * a.x + a.y * a.y) + (a.z * a.z + a.w * a.w); }

__device__ __forceinline__ void p0_transpose_item(const float* __restrict__ W, int K, int N, bf16* __restrict__ WT, LAS float* scr, int item, int lane) {
    const int nblk = N / 32, kb = item / nblk, nb = item % nblk, k0 = 64 * kb, n0 = 32 * nb;
#pragma unroll 8
    for (int i = 0; i < 32; ++i) { const int kk = 2 * i + (lane >> 5); scr[kk * 33 + (lane & 31)] = W[(size_t)(k0 + kk) * N + n0 + (lane & 31)]; }
    asm volatile("s_waitcnt lgkmcnt(0)" ::: "memory");
    const int c = lane & 7;
#pragma unroll
    for (int j = 0; j < 4; ++j) { const int n = (lane >> 3) + 8 * j; const LAS float* s = scr + (8 * c) * 33 + n;
        u32x4 o; o.x = pk2(s[0 * 33], s[1 * 33]); o.y = pk2(s[2 * 33], s[3 * 33]); o.z = pk2(s[4 * 33], s[5 * 33]); o.w = pk2(s[6 * 33], s[7 * 33]);
        *(u32x4*)(WT + (size_t)(n0 + n) * K + k0 + 8 * c) = o; }
    asm volatile("s_waitcnt lgkmcnt(0)" ::: "memory");
}

__device__ __forceinline__ void rms_row_to_bf16(const float* __restrict__ src, const float* __restrict__ g, bf16* __restrict__ dst, int lane) {
    f32x4 v[4][2]; float ss = 0.f;
#pragma unroll
    for (int j = 0; j < 4; ++j) { const float* p = src + 8 * (lane + 64 * j); v[j][0] = *(const f32x4*)p; v[j][1] = *(const f32x4*)(p + 4); ss += sumsq4(v[j][0]) + sumsq4(v[j][1]); }
    const float rstd = 1.0f / sqrtf(wave_sum(ss) * (1.0f / DM) + EPS);
#pragma unroll
    for (int j = 0; j < 4; ++j) { const int c = 8 * (lane + 64 * j); const f32x4 g0 = *(const f32x4*)(g + c), g1 = *(const f32x4*)(g + c + 4);
        *(u32x4*)(dst + c) = pack8(v[j][0] * rstd * g0, v[j][1] * rstd * g1); }
}

struct Args { const float* in[20]; float* out; unsigned char* ws; int ph_lo, ph_hi; };
constexpr int N_PHASES = 10;

__global__ void __launch_bounds__(NWAVES * 64, 2) mk_fwd(Args args) {
    extern __shared__ __attribute__((aligned(16))) unsigned char lds[];
    cg::grid_group grid = cg::this_grid();
    const int tid = threadIdx.x, lane = tid & 63, wave = __builtin_amdgcn_readfirstlane(tid >> 6);
    const int G = gridDim.x, bid = blockIdx.x;
    const int gw = bid * NWAVES + wave, NGW = G * NWAVES;
    unsigned char* ws = args.ws;
    const float* x_p = args.in[0]; const float* x_s = args.in[1]; const float* mem_p = args.in[2]; const float* mem_s = args.in[3];
    const float* rel_bias = args.in[4]; const float* g_premix = args.in[5]; const float* w_in = args.in[6]; const float* g_qn = args.in[7]; const float* g_kn = args.in[8];
    const float* g_mem = args.in[9]; const float* w_mem = args.in[10]; const float* g_oa = args.in[11]; const float* g_ob = args.in[12]; const float* g_om = args.in[13];
    const float* w_out = args.in[14]; const float* g_postmix = args.in[15]; const float* g_preffn = args.in[16]; const float* w_up = args.in[17]; const float* w_down = args.in[18];
    const float* g_postffn = args.in[19];
    float* out = args.out;
    f32x2* ROPE = (f32x2*)(ws + WS_ROPE);
    bf16* WIN = (bf16*)(ws + WS_WIN); bf16* WMEM = (bf16*)(ws + WS_WMEM); bf16* WOUT = (bf16*)(ws + WS_WOUT); bf16* WUP = (bf16*)(ws + WS_WUP); bf16* WDOWN = (bf16*)(ws + WS_WDOWN);
    float* LSE = (float*)(ws + WS_LSE); bf16* KVM = (bf16*)(ws + WS_KVM); bf16* H = (bf16*)(ws + WS_H); bf16* U = (bf16*)(ws + WS_U);
    bf16* QKV = U; bf16* Y3 = U; bf16* MIX = H; bf16* H2 = H; bf16* Y5 = H;
    LAS unsigned char* ldsl = (LAS unsigned char*)lds;
    const int lo = args.ph_lo, hi = args.ph_hi;
    volatile LAS unsigned* MISC = (volatile LAS unsigned*)(ldsl + RING_BYTES);
    if (tid < 64) MISC[tid] = 0u;
    __syncthreads();
    XcdBarrier xbar; xbar.bar = (unsigned*)ws; xbar.x = 0; xbar.st = MISC + 8;
    if (hi - lo > 1) xbar = xcd_barrier_post((unsigned*)ws, MISC + 8);
#define IN(k) (lo <= (k) && (k) < hi)
#ifndef REP_SYNC
#define REP_SYNC 1
#endif
#define SEAM(k) do { if (IN(k) && IN((k) + 1)) { for (int s_ = 0; s_ < REP_SYNC; ++s_) { if ((k) == 0) grid.sync(); else xcd_barrier(xbar); } } } while (0)
#define XROW(m) ((m) < TOK_P ? x_p + (size_t)(m) * DM : x_s + (size_t)((m) - TOK_P) * DM)

    if (IN(0)) {
        LAS float* scr = (LAS float*)(ldsl + wave * 16384);
        constexpr int I_IN = (DM / 64) * (INC / 32), I_MEM = (DM / 64) * (MEMKV / 32), I_OUT = (DM / 64) * (DM / 32), I_UP = (DM / 64) * (DFF / 32), I_DN = (DFF / 64) * (DM / 32);
        constexpr int NITEMS = I_IN + I_MEM + I_OUT + I_UP + I_DN;
        for (int it = gw; it < NITEMS; it += NGW) {
            int r = it;
            if (r < I_IN) { p0_transpose_item(w_in, DM, INC, WIN, scr, r, lane); continue; } r -= I_IN;
            if (r < I_MEM) { p0_transpose_item(w_mem, DM, MEMKV, WMEM, scr, r, lane); continue; } r -= I_MEM;
            if (r < I_OUT) { p0_transpose_item(w_out, DM, DM, WOUT, scr, r, lane); continue; } r -= I_OUT;
            if (r < I_UP) { p0_transpose_item(w_up, DM, DFF, WUP, scr, r, lane); continue; } r -= I_UP;
            p0_transpose_item(w_down, DFF, DM, WDOWN, scr, r, lane);
        }
        { const int gt = bid * (NWAVES * 64) + tid; if (gt < 64 * 32) { const int pos = gt >> 5, j = gt & 31; const float inv = powf(10000.0f, -(2.0f * (float)j) / 64.0f); const float ang = (float)pos * inv;
            ROPE[gt] = (f32x2){cosf(ang), sinf(ang)}; } }
        for (int m = gw; m < TOK + MEMROWS; m += NGW) {
            const float* src; const float* g = g_premix;
            if (m < TOK) src = XROW(m);
            else { const int mm = m - TOK; g = g_mem; src = mm < NB_P * NMEM ? mem_p + (size_t)mm * DM : mem_s + (size_t)(mm - NB_P * NMEM) * DM; }
            rms_row_to_bf16(src, g, H + (size_t)m * DM, lane);
        }
    }
    SEAM(0);

    if (IN(1)) {
        pg8::Gemm g{H, WIN, TOK + MEMROWS, INC + MEMKV, DM}; pg8::OrderWithMem S; S.so.init(TOK, INC, G, bid); S.nextra = (MEMROWS / 256) * (MEMKV / 256);
        pg8::EpiOut<0, true> E{QKV, INC, KVM, MEMKV};
        pg8::gemm_phase<pg8::EpiOut<0, true>, pg8::OrderWithMem, true, true>(ldsl, g, S, E);
    }
    SEAM(1);

    if (IN(2)) {
        const int half = lane >> 5, j = lane & 31;
        const float gq1 = g_qn[64 * half + j], gq2 = g_qn[64 * half + j + 32], gk1 = g_kn[64 * half + j], gk2 = g_kn[64 * half + j + 32];
        for (int t = gw; t < TOK; t += NGW) {
            const int s = t & (SEQ - 1); const int pos = half ? (s & 63) : (s >> 6);
            const f32x2 cs = ROPE[pos * 32 + j];
            bf16* row = QKV + (size_t)t * INC + 64 * half + j;
#pragma unroll
            for (int h8 = 0; h8 < 8; ++h8) {
                const float x1 = bflo((unsigned)row[h8 * 128]), x2 = bflo((unsigned)row[h8 * 128 + 32]);
                const float rstd = 1.0f / sqrtf(wave_sum(x1 * x1 + x2 * x2) * (1.0f / 128.0f) + EPS);
                const float a1 = x1 * rstd * (h8 < 6 ? gq1 : gk1), a2 = x2 * rstd * (h8 < 6 ? gq2 : gk2);
                row[h8 * 128] = (bf16)f2bf(a1 * cs.x - a2 * cs.y); row[h8 * 128 + 32] = (bf16)f2bf(a2 * cs.x + a1 * cs.y);
            }
        }
    }
    SEAM(2);

    if (IN(3)) {
        constexpr int NA = NBATCH * 6 * 8, NBU = NBATCH * 6 * 8, NMU = NBATCH * 4 * 8;
        for (int uu = bid; uu < NA * REP_ATTN; uu += G) { const int u = uu % NA;
            const int qb = u & 7, hq = (u >> 3) % 6, b = u / 48; const size_t r0 = (size_t)b * SEQ;
            att::attn_unit<0>(QKV + (r0 + qb * 256) * INC + C_QA + hq * 128, QKV + r0 * INC + C_KA + (hq / 3) * 128, QKV + r0 * INC + C_VA + (hq / 3) * 128,
                              MIX + (r0 + qb * 256) * DM + hq * 128, nullptr, INC, SEQ / 64, 1, 0, 0, 0, nullptr, (char*)lds);
        }
        __syncthreads();
        for (int vv = (bid + 64) % G; vv < NBU * REP_ATTN; vv += G) { const int v = vv % NBU;
            const int chunk = v & 7, head = (v >> 3) % 6, b = v / 48, gi = head >> 1; const size_t r0 = (size_t)b * SEQ;
            int dil, two, m0, ms, c, NT;
            if (gi == 0) { dil = 1; two = 0; c = 0; m0 = 256 * chunk; NT = 6; ms = min(max(m0 - 64, 0), SEQ - 384); }
            else if (gi == 1) { dil = 4; two = 0; c = chunk >> 1; m0 = 256 * (chunk & 1); NT = 6; ms = min(max(m0 - 64, 0), SEQ / 4 - 384); }
            else { dil = 16; two = 1; c = 2 * chunk; m0 = 0; ms = 0; NT = 4; }
            const size_t rq = r0 + c + (size_t)m0 * dil, rk = r0 + c;
            att::attn_unit_band(QKV + rq * INC + C_QB + head * 128, QKV + rk * INC + C_KB + head * 128, QKV + rk * INC + C_VB + head * 128,
                                MIX + rq * DM + 768 + head * 128, LSE + rq * 6 + head, INC, NT, dil, two, m0, ms, rel_bias + head, (char*)lds);
        }
        __syncthreads();
        for (int vv = (bid + 128) % G; vv < NMU * REP_ATTN; vv += G) { const int v = vv % NMU;
            const int qb = v & 7, hm = (v >> 3) & 3, b = v >> 5; const size_t r0 = (size_t)b * SEQ;
            att::attn_unit<0>(QKV + (r0 + qb * 256) * INC + C_QM + hm * 128, KVM + (size_t)b * NMEM * MEMKV + hm * 128, KVM + (size_t)b * NMEM * MEMKV + 512 + hm * 128,
                              MIX + (r0 + qb * 256) * DM + 1536 + hm * 128, nullptr, MEMKV, NMEM / 64, 1, 0, 0, 0, nullptr, (char*)lds);
        }
    }
    SEAM(3);

    if (IN(4)) {
        for (int t = gw; t < TOK; t += NGW) {
            bf16* row = MIX + (size_t)t * DM; const float* ls = LSE + (size_t)t * 6;
            float al[6];
            { float l[6];
#pragma unroll
              for (int i = 0; i < 6; ++i) l[i] = ls[i];
#pragma unroll
              for (int hp = 0; hp < 2; ++hp) { const float mx = fmaxf(fmaxf(l[hp], l[2 + hp]), l[4 + hp]);
                const float e0 = __expf(l[hp] - mx), e1 = __expf(l[2 + hp] - mx), e2 = __expf(l[4 + hp] - mx), inv = 1.0f / (e0 + e1 + e2);
                al[hp] = e0 * inv; al[2 + hp] = e1 * inv; al[4 + hp] = e2 * inv; } }
            f32x4 v[4][2]; float ssA = 0.f, ssB = 0.f, ssM = 0.f;
#pragma unroll
            for (int j = 0; j < 4; ++j) { const int c = 8 * (lane + 64 * j); unpack8(*(const u32x4*)(row + c), v[j][0], v[j][1]);
                const int seg = c < 768 ? 0 : (c < 1536 ? 1 : 2);
                if (seg == 1) { const int hb = (c - 768) >> 7; float a = al[0];
#pragma unroll
                    for (int i = 1; i < 6; ++i) a = (hb == i) ? al[i] : a;
                    v[j][0] = v[j][0] * a; v[j][1] = v[j][1] * a; }
                const float q = sumsq4(v[j][0]) + sumsq4(v[j][1]);
                ssA += seg == 0 ? q : 0.f; ssB += seg == 1 ? q : 0.f; ssM += seg == 2 ? q : 0.f; }
            const float rA = 1.0f / sqrtf(wave_sum(ssA) * (1.0f / 768.0f) + EPS), rB = 1.0f / sqrtf(wave_sum(ssB) * (1.0f / 768.0f) + EPS), rM = 1.0f / sqrtf(wave_sum(ssM) * (1.0f / 512.0f) + EPS);
#pragma unroll
            for (int j = 0; j < 4; ++j) { const int c = 8 * (lane + 64 * j); const int seg = c < 768 ? 0 : (c < 1536 ? 1 : 2);
                const float* gp = seg == 0 ? g_oa + c : (seg == 1 ? g_ob + (c - 768) : g_om + (c - 1536)); const float r = seg == 0 ? rA : (seg == 1 ? rB : rM);
                const f32x4 g0 = *(const f32x4*)gp, g1 = *(const f32x4*)(gp + 4);
                *(u32x4*)(row + c) = pack8(v[j][0] * r * g0, v[j][1] * r * g1); }
        }
    }
    SEAM(4);

    if (IN(5)) {
        pg8::Gemm g{MIX, WOUT, TOK, DM, DM}; pg8::StaticOrder S; S.init(TOK, DM, G, bid);
        pg8::EpiOut<0, false> E{Y3, DM, nullptr, 0};
        pg8::gemm_phase<pg8::EpiOut<0, false>, pg8::StaticOrder, true, true>(ldsl, g, S, E);
    }
    SEAM(5);

    if (IN(6)) {
        for (int t = gw; t < TOK; t += NGW) {
            const float* xr = XROW(t); const bf16* yr = Y3 + (size_t)t * DM; float* orow = out + (size_t)t * DM;
            f32x4 v[4][2]; float ss = 0.f;
#pragma unroll
            for (int j = 0; j < 4; ++j) { const int c = 8 * (lane + 64 * j); unpack8(*(const u32x4*)(yr + c), v[j][0], v[j][1]); ss += sumsq4(v[j][0]) + sumsq4(v[j][1]); }
            const float r3 = 1.0f / sqrtf(wave_sum(ss) * (1.0f / DM) + EPS); float s1 = 0.f;
#pragma unroll
            for (int j = 0; j < 4; ++j) { const int c = 8 * (lane + 64 * j);
                const f32x4 g0 = *(const f32x4*)(g_postmix + c), g1 = *(const f32x4*)(g_postmix + c + 4), x0 = *(const f32x4*)(xr + c), x1 = *(const f32x4*)(xr + c + 4);
                v[j][0] = x0 + v[j][0] * r3 * g0; v[j][1] = x1 + v[j][1] * r3 * g1;
                *(f32x4*)(orow + c) = v[j][0]; *(f32x4*)(orow + c + 4) = v[j][1]; s1 += sumsq4(v[j][0]) + sumsq4(v[j][1]); }
            const float r1 = 1.0f / sqrtf(wave_sum(s1) * (1.0f / DM) + EPS);
#pragma unroll
            for (int j = 0; j < 4; ++j) { const int c = 8 * (lane + 64 * j); const f32x4 g0 = *(const f32x4*)(g_preffn + c), g1 = *(const f32x4*)(g_preffn + c + 4);
                *(u32x4*)(H2 + (size_t)t * DM + c) = pack8(v[j][0] * r1 * g0, v[j][1] * r1 * g1); }
        }
    }
    SEAM(6);

    if (IN(7)) {
        pg8::Gemm g{H2, WUP, TOK, DFF, DM}; pg8::StaticOrder S; S.init(TOK, DFF, G, bid);
        pg8::EpiOut<2, false> E{U, DFF, nullptr, 0};
        pg8::gemm_phase<pg8::EpiOut<2, false>, pg8::StaticOrder, true, true>(ldsl, g, S, E);
    }
    SEAM(7);

    if (IN(8)) {
        pg8::Gemm g{U, WDOWN, TOK, DM, DFF}; pg8::StaticOrder S; S.init(TOK, DM, G, bid);
        pg8::EpiOut<0, false> E{Y5, DM, nullptr, 0};
        pg8::gemm_phase<pg8::EpiOut<0, false>, pg8::StaticOrder, true, true>(ldsl, g, S, E);
    }
    SEAM(8);

    if (IN(9)) {
        for (int t = gw; t < TOK; t += NGW) {
            const bf16* yr = Y5 + (size_t)t * DM; float* orow = out + (size_t)t * DM;
            f32x4 v[4][2]; float ss = 0.f;
#pragma unroll
            for (int j = 0; j < 4; ++j) { const int c = 8 * (lane + 64 * j); unpack8(*(const u32x4*)(yr + c), v[j][0], v[j][1]); ss += sumsq4(v[j][0]) + sumsq4(v[j][1]); }
            const float r5 = 1.0f / sqrtf(wave_sum(ss) * (1.0f / DM) + EPS);
#pragma unroll
            for (int j = 0; j < 4; ++j) { const int c = 8 * (lane + 64 * j);
                const f32x4 g0 = *(const f32x4*)(g_postffn + c), g1 = *(const f32x4*)(g_postffn + c + 4), x0 = *(const f32x4*)(orow + c), x1 = *(const f32x4*)(orow + c + 4);
                *(f32x4*)(orow + c) = x0 + v[j][0] * r5 * g0; *(f32x4*)(orow + c + 4) = x1 + v[j][1] * r5 * g1; }
        }
    }
#undef IN
#undef SEAM
#undef XROW
}

#ifndef MK_N_LAUNCHES
#define MK_N_LAUNCHES 1
#endif
extern "C" void kernel_launch(void* const* d_in, const int* in_sizes, int n_in, void* d_out, int out_size, void* d_ws, size_t ws_size, hipStream_t stream) {
    static int grid = 0;
    if (grid == 0) {
        if (n_in != 20 || in_sizes[0] != TOK_P * DM || in_sizes[1] != (TOK - TOK_P) * DM || out_size != TOK * DM || ws_size < WS_END) {
            fprintf(stderr, "kernel_launch: shape mismatch: n_in %d in0 %d in1 %d out %d ws %zu (need %zu); nothing launched\n", n_in, n_in > 0 ? in_sizes[0] : -1, n_in > 1 ? in_sizes[1] : -1, out_size, ws_size, (size_t)WS_END);
            grid = -1; return; }
        int dev = 0, cus = 0, per_cu = 0;
        if (hipGetDevice(&dev) != hipSuccess || hipDeviceGetAttribute(&cus, hipDeviceAttributeMultiprocessorCount, dev) != hipSuccess) { fprintf(stderr, "kernel_launch: device query failed\n"); grid = -1; return; }
        if (hipFuncSetAttribute((const void*)mk_fwd, hipFuncAttributeMaxDynamicSharedMemorySize, LDS_BYTES) != hipSuccess) { fprintf(stderr, "kernel_launch: hipFuncSetAttribute failed\n"); grid = -1; return; }
        if (hipOccupancyMaxActiveBlocksPerMultiprocessor(&per_cu, (const void*)mk_fwd, NWAVES * 64, LDS_BYTES) != hipSuccess || per_cu < 1) { fprintf(stderr, "kernel_launch: occupancy query says %d\n", per_cu); per_cu = 1; }
        (void)hipGetLastError();
        grid = cus * per_cu;
    }
    if (grid < 0) return;
    if (hipMemsetAsync(d_ws, 0, 16384, stream) != hipSuccess) { fprintf(stderr, "kernel_launch: memset failed\n"); return; }
    Args a{};
    for (int i = 0; i < 20; ++i) a.in[i] = (const float*)d_in[i];
    a.out = (float*)d_out; a.ws = (unsigned char*)d_ws;
#if MK_N_LAUNCHES == 1
    a.ph_lo = 0; a.ph_hi = N_PHASES;
    void* kargs[] = {&a};
    const hipError_t e = hipLaunchCooperativeKernel((const void*)mk_fwd, dim3(grid), dim3(NWAVES * 64), kargs, LDS_BYTES, stream);
    if (e != hipSuccess) fprintf(stderr, "kernel_launch: cooperative launch failed: %s (grid %d)\n", hipGetErrorString(e), grid);
#else
    for (int p = 0; p < N_PHASES; ++p) { a.ph_lo = p; a.ph_hi = p + 1; hipLaunchKernelGGL(mk_fwd, dim3(grid), dim3(NWAVES * 64), LDS_BYTES, stream, a); }
#endif
}
```

```cpp
#include <hip/hip_runtime.h>
#include <hip/hip_cooperative_groups.h>
#include <cstdio>
#include <cstdint>
namespace cg = cooperative_groups;
#ifndef REP_GEMM
#define REP_GEMM 1
#endif
#ifndef REP_ATTN
#define REP_ATTN 1
#endif
#ifndef REP_ROW
#define REP_ROW 1
#endif
namespace pg8 {
#define PG8_LAS __attribute__((address_space(3)))
typedef unsigned short bf16_t;
typedef short bf16x8 __attribute__((ext_vector_type(8)));
typedef float f32x4 __attribute__((ext_vector_type(4)));
typedef unsigned u32x4 __attribute__((ext_vector_type(4)));
constexpr int BM = 256, BK = 64, HALF = 128, HTB = HALF * BK * 2  , STAGE_BYTES = 8 * HTB, NXCD = 8, WGM = 8;

__host__ __device__ __forceinline__ int lds_byte(int r, int c) { const int st = (r >> 4) * 2 + (c >> 5), rr = r & 15, cc = c & 31, ob = rr * 64 + cc * 2; return st * 1024 + (ob ^ (((ob >> 9) & 1) << 5)); }
__host__ __device__ __forceinline__ void stage_rc(int b, int& R, int& C) { const int st = b / 1024, sb = b % 1024, swz = sb ^ (((sb >> 9) & 1) << 5); R = (st >> 1) * 16 + swz / 64; C = (st & 1) * 32 + (swz % 64) / 2; }
__host__ __device__ __forceinline__ int perm32(int rho) { const int n = rho >> 4, i = rho & 15; return 8 * (i >> 2) + 4 * n + (i & 3); }

struct Unit { int pm, pn; };
struct Gemm { const bf16_t* A; const bf16_t* Bt; int M, N, K; };

struct StaticOrder {
    int nM, nN, nwg, G, c;
    __host__ __device__ void init(int M, int N, int G_, int c_) { nM = M / BM; nN = N / BM; nwg = nM * nN; G = G_; c = c_; }
    __host__ __device__ bool next(int i, Unit& u) const {
#if REP_GEMM > 1
        { const int per = nwg / G; if (i >= per * REP_GEMM) return false; i = i % per; }
#endif
        const long L = (long)i * G + c; if (L >= nwg) return false;
        int wgid = (int)L; { const int q = nwg / NXCD, r = nwg % NXCD, xcd = wgid % NXCD, off = wgid / NXCD; wgid = (xcd < r ? xcd * (q + 1) : r * (q + 1) + (xcd - r) * q) + off; }
        const int nig = WGM * nN, gid = wgid / nig, fm = gid * WGM, gsz = (nM - fm) < WGM ? (nM - fm) : WGM;
        u.pm = fm + ((wgid % nig) % gsz); u.pn = (wgid % nig) / gsz; return true;
    }
    __device__ __forceinline__ void a_ready(const Unit&) const {}
    __device__ __forceinline__ void done(const Unit&) const {}
};

__device__ __forceinline__ unsigned cvt_pk_bf16(float lo, float hi) { unsigned r; asm volatile("v_cvt_pk_bf16_f32 %0, %1, %2" : "=v"(r) : "v"(lo), "v"(hi)); return r; }
typedef float f32x2 __attribute__((ext_vector_type(2)));
template <int ACT, bool MEMSPLIT> struct EpiOut {
    static constexpr bool PERM = true, AFTER_DRAIN = false;
    static constexpr int SPLIT_PM = 160, SPLIT_PN = 16;
    bf16_t* O; int ldc; bf16_t* O2; int ldc2;
    __device__ __forceinline__ void operator()(const f32x4 (&acc)[2][2][4][2], const Unit& u, int wr, int wc, int fr, int fq) const {
        int row0 = u.pm * BM + wr * 64 + fr; int colt = u.pn * BM; bf16_t* base = O; int ld = ldc;
        if (MEMSPLIT) { if (u.pm >= SPLIT_PM) { base = O2; ld = ldc2; row0 -= SPLIT_PM * BM; colt -= SPLIT_PN * BM; } }
        const int col0 = colt + wc * 32 + 8 * fq;
#pragma unroll
        for (int ai = 0; ai < 2; ++ai)
#pragma unroll
            for (int m = 0; m < 4; ++m) { bf16_t* rowp = base + (size_t)(row0 + ai * HALF + m * 16) * ld + col0;
#pragma unroll
                for (int bj = 0; bj < 2; ++bj) { f32x4 v0 = acc[ai][bj][m][0], v1 = acc[ai][bj][m][1];
                    if (ACT == 2) {
#pragma unroll
                        for (int e = 0; e < 4; ++e) { const float a = fmaxf(v0[e], 0.f), b = fmaxf(v1[e], 0.f); v0[e] = a * a; v1[e] = b * b; } }
                    u32x4 w; w.x = cvt_pk_bf16(v0[0], v0[1]); w.y = cvt_pk_bf16(v0[2], v0[3]); w.z = cvt_pk_bf16(v1[0], v1[1]); w.w = cvt_pk_bf16(v1[2], v1[3]);
                    *(u32x4*)(rowp + bj * HALF) = w; } }
    }
};
struct OrderWithMem {
    StaticOrder so; int nextra;
    __host__ __device__ bool next(int i, Unit& u) const {
#if REP_GEMM > 1
        const int per = so.nwg / so.G; if (i < per * REP_GEMM) return so.next(i, u);
        const long L = (long)(i - per * (REP_GEMM - 1)) * so.G + so.c;
#else
        const long L = (long)i * so.G + so.c; if (L < so.nwg) return so.next(i, u);
#endif
        const int e = (int)(L - so.nwg); if (e >= nextra) return false;
        u.pm = 160 + e % 20; u.pn = 16 + e / 20; return true;
    }
    __device__ __forceinline__ void a_ready(const Unit&) const {}
    __device__ __forceinline__ void done(const Unit&) const {}
};

struct ExtraOnly {
    int e0, step, n;
    __host__ __device__ bool next(int i, Unit& u) const { const int e = e0 + i * step; if (e >= n) return false; u.pm = 160 + e % 20; u.pn = 16 + e / 20; return true; }
    __device__ __forceinline__ void a_ready(const Unit&) const {}
    __device__ __forceinline__ void done(const Unit&) const {}
};

template <class Epi, class Sched, bool ALIGN_EPI = false, bool SP2 = false>
__device__ __forceinline__ void gemm_phase(PG8_LAS unsigned char* lds, const Gemm g, const Sched& S, const Epi& E) {
    const int tid = threadIdx.x, wid = __builtin_amdgcn_readfirstlane(tid >> 6), lane = tid & 63, wr = wid >> 2, wc = wid & 3, fr = lane & 15, fq = lane >> 4;
    const int K = g.K, nt = K / BK;
    unsigned voffA[2], voffB[2];
#pragma unroll
    for (int i = 0; i < 2; ++i) { int R, C; stage_rc(tid * 16 + i * 8192, R, C); const int Rb = Epi::PERM ? ((R & ~31) + perm32(R & 31)) : R;
        voffA[i] = (unsigned)(R * K + C) * 2u; voffB[i] = (unsigned)(Rb * K + C) * 2u; }
    const size_t kstep = (size_t)(BK * 2);
    const size_t hstep = (size_t)HALF * K * 2;
    const size_t tstep = 2 * hstep;
    const unsigned ldsw = (unsigned)wid * 1024u;
    const int aoff = lds_byte(wr * 64 + fr, fq * 8), boff = lds_byte(wc * 32 + fr, fq * 8);
#define PG8_SA(b, h) (((b) * 2 + (h)) * HTB)
#define PG8_SB(b, h) ((4 + (b) * 2 + (h)) * HTB)
#define PG8_STAGE(bufoff, gbase, voff) do { _Pragma("unroll") for (int _i = 0; _i < 2; ++_i) \
        __builtin_amdgcn_global_load_lds((const unsigned*)((const char*)(gbase) + (voff)[_i]), (PG8_LAS unsigned*)(lds + (bufoff) + ldsw + _i * 8192), 16, 0, 0); } while (0)
#define PG8_LDA(dst, b, h) do { _Pragma("unroll") for (int m = 0; m < 4; ++m) _Pragma("unroll") for (int k = 0; k < 2; ++k) dst[m][k] = *(const PG8_LAS bf16x8*)(lds + PG8_SA(b, h) + aoff + m * 2048 + k * 1024); } while (0)
#define PG8_LDB(dst, b, h) do { _Pragma("unroll") for (int n = 0; n < 2; ++n) _Pragma("unroll") for (int k = 0; k < 2; ++k) dst[n][k] = *(const PG8_LAS bf16x8*)(lds + PG8_SB(b, h) + boff + n * 2048 + k * 1024); } while (0)
#define PG8_MMA(ai, bj, At, Bt) do { __builtin_amdgcn_s_setprio(1); _Pragma("unroll") for (int m = 0; m < 4; ++m) _Pragma("unroll") for (int n = 0; n < 2; ++n) _Pragma("unroll") for (int k = 0; k < 2; ++k) \
        acc[ai][bj][m][n] = __builtin_amdgcn_mfma_f32_16x16x32_bf16(Bt[n][k], At[m][k], acc[ai][bj][m][n], 0, 0, 0); __builtin_amdgcn_s_setprio(0); } while (0)
#define PG8_WAIT_V(n) asm volatile("s_waitcnt vmcnt(" #n ")" ::: "memory")
#define PG8_WAIT_L(n) asm volatile("s_waitcnt lgkmcnt(" #n ")" ::: "memory")
#define PG8_BAR __builtin_amdgcn_s_barrier()
#define PG8_SCHED __builtin_amdgcn_sched_barrier(0)
    Unit cur, nxt; int ui = 0;
    if (!S.next(0, cur)) return;
    f32x4 acc[2][2][4][2];
#pragma unroll
    for (int a = 0; a < 2; ++a)
#pragma unroll
        for (int b = 0; b < 2; ++b)
#pragma unroll
            for (int m = 0; m < 4; ++m)
#pragma unroll
                for (int n = 0; n < 2; ++n) acc[a][b][m][n] = (f32x4){0.f, 0.f, 0.f, 0.f};
    bf16x8 At[4][2], B0[2][2], B1[2][2];
    const char* cA = (const char*)g.A + (size_t)cur.pm * tstep; const char* cB = (const char*)g.Bt + (size_t)cur.pn * tstep;
    S.a_ready(cur);
    if constexpr (SP2) {
        PG8_STAGE(PG8_SB(0, 0), cB, voffB); PG8_STAGE(PG8_SB(0, 1), cB + hstep, voffB); PG8_STAGE(PG8_SA(0, 0), cA, voffA); PG8_STAGE(PG8_SA(0, 1), cA + hstep, voffA);
        if (wr == 1) PG8_BAR;
        PG8_WAIT_V(2); PG8_BAR;
        PG8_STAGE(PG8_SB(1, 0), cB + kstep, voffB); PG8_STAGE(PG8_SA(1, 0), cA + kstep, voffA); PG8_STAGE(PG8_SB(1, 1), cB + hstep + kstep, voffB);
        PG8_WAIT_V(6); PG8_BAR;
    } else {
        PG8_STAGE(PG8_SB(0, 0), cB, voffB); PG8_STAGE(PG8_SA(0, 0), cA, voffA); PG8_STAGE(PG8_SB(0, 1), cB + hstep, voffB); PG8_STAGE(PG8_SA(0, 1), cA + hstep, voffA);
        if (wr == 1) PG8_BAR;
        PG8_WAIT_V(4); PG8_BAR;
        PG8_STAGE(PG8_SB(1, 0), cB + kstep, voffB); PG8_STAGE(PG8_SA(1, 0), cA + kstep, voffA); PG8_STAGE(PG8_SB(1, 1), cB + hstep + kstep, voffB);
        PG8_WAIT_V(6); PG8_BAR;
    }
    for (;;) {
        const bool has_next = S.next(ui + 1, nxt);
        const char* nA = has_next ? (const char*)g.A + (size_t)nxt.pm * tstep : cA; const char* nB = has_next ? (const char*)g.Bt + (size_t)nxt.pn * tstep : cB;
        for (int t = 0; t < nt; t += 2) {
            const bool last = (t == nt - 2);
            const char* a1 = cA + (size_t)(t + 1) * kstep;
            const char* a2 = last ? nA : cA + (size_t)(t + 2) * kstep; const char* b2 = last ? nB : cB + (size_t)(t + 2) * kstep;
            const char* a3 = a2 + kstep; const char* b3 = b2 + kstep;
            if (last && has_next) S.a_ready(nxt);
            if constexpr (SP2) {
            PG8_LDB(B0, 0, 0); PG8_LDB(B1, 0, 1); PG8_SCHED; PG8_LDA(At, 0, 0); PG8_STAGE(PG8_SA(1, 1), a1 + hstep, voffA);
            PG8_WAIT_V(8); PG8_WAIT_L(0); PG8_BAR; PG8_MMA(0, 0, At, B0); PG8_MMA(0, 1, At, B1); PG8_BAR; PG8_SCHED;
            PG8_LDA(At, 0, 1); PG8_STAGE(PG8_SB(0, 0), b2, voffB); PG8_STAGE(PG8_SB(0, 1), b2 + hstep, voffB); PG8_STAGE(PG8_SA(0, 0), a2, voffA);
            PG8_WAIT_V(8); PG8_WAIT_L(0); PG8_BAR; PG8_MMA(1, 0, At, B0); PG8_MMA(1, 1, At, B1); PG8_BAR; PG8_SCHED;
            PG8_LDB(B0, 1, 0); PG8_LDB(B1, 1, 1); PG8_SCHED; PG8_LDA(At, 1, 0); PG8_STAGE(PG8_SA(0, 1), a2 + hstep, voffA);
            PG8_WAIT_V(8); PG8_WAIT_L(0); PG8_BAR; PG8_MMA(0, 0, At, B0); PG8_MMA(0, 1, At, B1); PG8_BAR; PG8_SCHED;
            PG8_LDA(At, 1, 1); PG8_STAGE(PG8_SB(1, 0), b3, voffB); PG8_STAGE(PG8_SB(1, 1), b3 + hstep, voffB); PG8_STAGE(PG8_SA(1, 0), a3, voffA);
            PG8_WAIT_V(8); PG8_WAIT_L(0); PG8_BAR; PG8_MMA(1, 0, At, B0); PG8_MMA(1, 1, At, B1); PG8_BAR; PG8_SCHED;
            } else {
            PG8_LDB(B0, 0, 0); PG8_SCHED; PG8_LDA(At, 0, 0); PG8_STAGE(PG8_SA(1, 1), a1 + hstep, voffA);
            PG8_WAIT_L(8); PG8_BAR; PG8_WAIT_L(0); PG8_MMA(0, 0, At, B0); PG8_BAR; PG8_SCHED;
            PG8_LDB(B1, 0, 1); PG8_STAGE(PG8_SB(0, 0), b2, voffB);
            PG8_BAR; PG8_WAIT_L(0); PG8_MMA(0, 1, At, B1); PG8_BAR;
            PG8_LDA(At, 0, 1); PG8_STAGE(PG8_SA(0, 0), a2, voffA);
            PG8_BAR; PG8_WAIT_L(0); PG8_MMA(1, 0, At, B0); PG8_BAR; PG8_SCHED;
            PG8_STAGE(PG8_SB(0, 1), b2 + hstep, voffB);
            PG8_WAIT_V(6); PG8_BAR; PG8_MMA(1, 1, At, B1); PG8_BAR;
            PG8_LDB(B0, 1, 0); PG8_SCHED; PG8_LDA(At, 1, 0); PG8_STAGE(PG8_SA(0, 1), a2 + hstep, voffA);
            PG8_WAIT_L(8); PG8_BAR; PG8_WAIT_L(0); PG8_MMA(0, 0, At, B0); PG8_BAR; PG8_SCHED;
            PG8_LDB(B1, 1, 1); PG8_STAGE(PG8_SB(1, 0), b3, voffB);
            PG8_BAR; PG8_WAIT_L(0); PG8_MMA(0, 1, At, B1); PG8_BAR;
            PG8_LDA(At, 1, 1); PG8_STAGE(PG8_SA(1, 0), a3, voffA);
            PG8_BAR; PG8_WAIT_L(0); PG8_MMA(1, 0, At, B0); PG8_BAR; PG8_SCHED;
            PG8_STAGE(PG8_SB(1, 1), b3 + hstep, voffB);
            PG8_WAIT_V(6); PG8_BAR; PG8_MMA(1, 1, At, B1); PG8_BAR;
            }
        }
        if constexpr (ALIGN_EPI) { if (wr == 0) PG8_BAR; }
        if constexpr (!Epi::AFTER_DRAIN) { E(acc, cur, wr, wc, fr, fq); S.done(cur); }
        if (!has_next) break;
#pragma unroll
        for (int a = 0; a < 2; ++a)
#pragma unroll
            for (int b = 0; b < 2; ++b)
#pragma unroll
                for (int m = 0; m < 4; ++m)
#pragma unroll
                    for (int n = 0; n < 2; ++n) acc[a][b][m][n] = (f32x4){0.f, 0.f, 0.f, 0.f};
        cur = nxt; cA = nA; cB = nB; ++ui;
        if constexpr (ALIGN_EPI) { if (wr == 1) PG8_BAR; }
    }
    PG8_WAIT_V(0);
    if constexpr (!ALIGN_EPI) { if (wr == 0) PG8_BAR; }
    PG8_BAR;
    if constexpr (Epi::AFTER_DRAIN) { E.fused(acc, cur, wr, wc, fr, fq, lds, wid, lane); S.done(cur); }
#undef PG8_SA
#undef PG8_SB
#undef PG8_STAGE
#undef PG8_LDA
#undef PG8_LDB
#undef PG8_MMA
#undef PG8_WAIT_V
#undef PG8_WAIT_L
#undef PG8_BAR
#undef PG8_SCHED
}
}
namespace att {
using bf16 = unsigned short;
constexpr int   D = 128, NW = 8, QBLK = 32, KVBLK = 64;
constexpr float SCALE = 0.088388347648318440f;
constexpr float THR = 8.f;
constexpr float MINIT = -30000.f;
constexpr size_t SHM_V = KVBLK * D * 2, SHM_K = KVBLK * D * 2;
constexpr size_t SHM_ATTN = 2 * SHM_V + 2 * SHM_K + NW * 64 * 4 + 1024;
using bf16x8 = __attribute__((ext_vector_type(8))) short;
using s16x4  = __attribute__((ext_vector_type(4))) short;
using f32x16 = __attribute__((ext_vector_type(16))) float;
using u32x4  = __attribute__((ext_vector_type(4))) unsigned;
#define KSWZ(row, colB) ((row) * 256 + ((colB) ^ (((row) & 7) << 4)))
#define SBAR() __builtin_amdgcn_sched_barrier(0)
__device__ __forceinline__ int crow(int r, int hi) { return (r & 3) + 8 * (r >> 2) + 4 * hi; }
__device__ __forceinline__ unsigned cvtpk(float lo, float hi) {
  unsigned r; asm volatile("v_cvt_pk_bf16_f32 %0, %1, %2" : "=v"(r) : "v"(lo), "v"(hi)); return r;
}
__device__ __forceinline__ void partialSM(f32x16& p0, f32x16& p1, float& m_reg, float& mn, float& alpha) {
  constexpr float C = SCALE * 1.4426950408889634f;
  float pmax = p0[0]; for (int r = 1; r < 16; ++r) pmax = fmaxf(pmax, p0[r]); for (int r = 0; r < 16; ++r) pmax = fmaxf(pmax, p1[r]);
  { auto rr = __builtin_amdgcn_permlane32_swap(__float_as_uint(pmax), __float_as_uint(pmax), false, false);
    pmax = fmaxf(__uint_as_float(rr[0]), __uint_as_float(rr[1])); }
  if (__builtin_expect(__all(pmax - m_reg <= THR / SCALE), 1)) { mn = m_reg; alpha = 1.f; }
  else { mn = fmaxf(m_reg, pmax); alpha = __builtin_amdgcn_exp2f((m_reg - mn) * C); m_reg = mn; }
  float mnC = -mn * C;
  for (int r = 0; r < 16; ++r) p0[r] = fmaf(p0[r], C, mnC); for (int r = 0; r < 16; ++r) p1[r] = fmaf(p1[r], C, mnC);
  for (int r = 0; r < 16; ++r) p0[r] = __builtin_amdgcn_exp2f(p0[r]);
}
__device__ __forceinline__ void finishSM(f32x16& p0, f32x16& p1, float alpha, float& l_reg, bf16x8& pa0, bf16x8& pa1, bf16x8& pa2, bf16x8& pa3) {
  for (int r = 0; r < 16; ++r) p1[r] = __builtin_amdgcn_exp2f(p1[r]);
  float ps = 0; for (int r = 0; r < 16; ++r) ps += p0[r]; for (int r = 0; r < 16; ++r) ps += p1[r];
  { auto rr = __builtin_amdgcn_permlane32_swap(__float_as_uint(ps), __float_as_uint(ps), false, false);
    ps = __uint_as_float(rr[0]) + __uint_as_float(rr[1]); }
  l_reg = l_reg * alpha + ps;
#define PK4(P, BASE, OUT) do { unsigned a0 = cvtpk(P[BASE + 0], P[BASE + 1]), a1 = cvtpk(P[BASE + 2], P[BASE + 3]);   \
    unsigned b0 = cvtpk(P[BASE + 4], P[BASE + 5]), b1 = cvtpk(P[BASE + 6], P[BASE + 7]);                              \
    auto r0 = __builtin_amdgcn_permlane32_swap(a0, b0, false, false); auto r1 = __builtin_amdgcn_permlane32_swap(a1, b1, false, false); \
    u32x4 w = {r0[0], r1[0], r0[1], r1[1]}; OUT = *reinterpret_cast<bf16x8*>(&w); } while (0)
  PK4(p0, 0, pa0); PK4(p0, 8, pa1); PK4(p1, 0, pa2); PK4(p1, 8, pa3);
#undef PK4
}
__device__ __forceinline__ void qkt(f32x16& p0, f32x16& p1, const bf16* Ks, const bf16x8* qr, int r32, int hi) {
  p0 = f32x16{}; p1 = f32x16{};
  for (int d0 = 0; d0 < 8; ++d0) { int cb = (d0 * 16 + hi * 8) * 2;
    bf16x8 b0 = *reinterpret_cast<const bf16x8*>((const char*)Ks + KSWZ(r32, cb));
    bf16x8 b1 = *reinterpret_cast<const bf16x8*>((const char*)Ks + KSWZ(32 + r32, cb));
    p0 = __builtin_amdgcn_mfma_f32_32x32x16_bf16(b0, qr[d0], p0, 0, 0, 0);
    p1 = __builtin_amdgcn_mfma_f32_32x32x16_bf16(b1, qr[d0], p1, 0, 0, 0); }
}
__device__ __forceinline__ int v_st(int k, int c) { const int kk = (k & ~0xC) | ((k & 4) << 1) | ((k & 8) >> 1); return ((kk >> 3) * 4 + (c >> 5)) * 512 + ((kk & 7) * 32 + (c & 31)) * 2; }
__device__ __forceinline__ int v_rd_base(int lane) { return ((lane & 3) << 3) | (((lane >> 2) & 3) << 6) | (((lane >> 4) & 1) << 5) | (((lane >> 5) & 1) << 8); }
constexpr int v_rd_off(int d0, int ks, int half) { return d0 * 512 + ks * 4096 + half * 2048; }
template <int OFF> __device__ __forceinline__ s16x4 tr_read(int vb) {
  s16x4 r; asm volatile("ds_read_b64_tr_b16 %0, %1 offset:%2" : "=&v"(r) : "v"(vb), "i"(OFF) : "memory"); return r;
}
template <int D0> __device__ __forceinline__ void pv_one(f32x16& od, int vb, bf16x8 pa0, bf16x8 pa1, bf16x8 pa2, bf16x8 pa3) {
  const s16x4 l0 = tr_read<v_rd_off(D0, 0, 0)>(vb), h0 = tr_read<v_rd_off(D0, 0, 1)>(vb), l1 = tr_read<v_rd_off(D0, 1, 0)>(vb), h1 = tr_read<v_rd_off(D0, 1, 1)>(vb);
  const s16x4 l2 = tr_read<v_rd_off(D0, 2, 0)>(vb), h2 = tr_read<v_rd_off(D0, 2, 1)>(vb), l3 = tr_read<v_rd_off(D0, 3, 0)>(vb), h3 = tr_read<v_rd_off(D0, 3, 1)>(vb);
  asm volatile("s_waitcnt lgkmcnt(0)" ::: "memory"); SBAR();
#define PK(L, H) (bf16x8){L[0], L[1], L[2], L[3], H[0], H[1], H[2], H[3]}
  od = __builtin_amdgcn_mfma_f32_32x32x16_bf16(pa0, PK(l0, h0), od, 0, 0, 0);
  od = __builtin_amdgcn_mfma_f32_32x32x16_bf16(pa1, PK(l1, h1), od, 0, 0, 0);
  od = __builtin_amdgcn_mfma_f32_32x32x16_bf16(pa2, PK(l2, h2), od, 0, 0, 0);
  od = __builtin_amdgcn_mfma_f32_32x32x16_bf16(pa3, PK(l3, h3), od, 0, 0, 0);
#undef PK
}
__device__ __forceinline__ void pv_d0(f32x16* o, int vb, bf16x8 pa0, bf16x8 pa1, bf16x8 pa2, bf16x8 pa3) {
  pv_one<0>(o[0], vb, pa0, pa1, pa2, pa3); pv_one<1>(o[1], vb, pa0, pa1, pa2, pa3); pv_one<2>(o[2], vb, pa0, pa1, pa2, pa3); pv_one<3>(o[3], vb, pa0, pa1, pa2, pa3);
}
__device__ __forceinline__ void band_mask(f32x16& p0, f32x16& p1, int base, int hi, const float* biasL) {
#pragma unroll
  for (int r = 0; r < 16; ++r) {
    const int k0 = base + crow(r, hi), k1 = k0 + 32;
    const int c0 = min(max(k0, 0), 128), c1 = min(max(k1, 0), 128);
    const float b0 = biasL[c0], b1 = biasL[c1];
    p0[r] = ((unsigned)k0 <= 128u) ? p0[r] + b0 : MINIT;
    p1[r] = ((unsigned)k1 <= 128u) ? p1[r] + b1 : MINIT;
  }
}
__device__ __forceinline__ unsigned short f2bf(float f) { unsigned u = __builtin_bit_cast(unsigned, f); return (unsigned short)((u + 0x7fffu + ((u >> 16) & 1u)) >> 16); }

template <int MODE>
__device__ __forceinline__ void attn_unit(const bf16* __restrict__ Qh, const bf16* __restrict__ Kh, const bf16* __restrict__ Vh, bf16* __restrict__ Oh,
                                          float* __restrict__ lse_o, const int ldk, const int NT, const int dil, const int two, const int m0, const int ms,
                                          const float* __restrict__ bias_g, char* lds) {
  constexpr int LDQ = 4096, LDO = 2048;
  const int tid = threadIdx.x, wid = tid >> 6, lane = tid & 63, r32 = lane & 31, hi = lane >> 5;
  bf16* V_lds = (bf16*)lds; bf16* K_lds = (bf16*)(lds + 2 * SHM_V);
  float* ws = (float*)(lds + 2 * SHM_V + 2 * SHM_K) + wid * 64; float* li_l = ws; float* al_l = ws + 32;
  float* biasL = (float*)(lds + 2 * SHM_V + 2 * SHM_K + NW * 64 * 4);
  float m_reg = MINIT, l_reg = 0; f32x16 o[4] = {}; bf16x8 qr[8];
  const int qi = wid * QBLK + r32;
  int qt = qi, qpos = 0;
  if (MODE == 1) { qt = two ? ((qi & 127) * dil + (qi >> 7)) : qi * dil; qpos = two ? ((qi & 127) + 4096 * (qi >> 7)) : (m0 + qi); }
  const bf16* Qw = Qh + (long)qt * LDQ + hi * 8;
#pragma unroll
  for (int d0 = 0; d0 < 8; ++d0) qr[d0] = *reinterpret_cast<const bf16x8*>(Qw + d0 * 16);
  if (MODE == 1) {
    if (tid < 129) {
      const int rel = (tid - 64) * dil, n = rel < 0 ? -rel : rel; const float nf = (float)(n > 1 ? n : 1);
      int large = 8 + (int)(logf(nf * 0.125f) / 4.852030263919617f * 8.0f); large = large < 15 ? large : 15;
      const int bucket = (rel > 0 ? 16 : 0) + (n < 8 ? n : large);
      biasL[tid] = bias_g[bucket * 6] * (1.0f / SCALE);
    }
  }
  const int rs = (MODE == 1) ? dil : 1;
  const int sr = tid >> 4, sc = (tid & 15) * 8, vst0 = v_st(sr, sc), vst1 = v_st(32 + sr, sc);
  const int vb0 = (int)(uintptr_t)V_lds + v_rd_base(lane);
  const unsigned lo0 = (unsigned)(sr * rs * ldk + sc), lo1 = lo0 + (unsigned)(32 * rs * ldk);
  constexpr int SDEPTH = (MODE == 1) ? 1 : 2;
  struct { bf16x8 vs0, vs1, ks0, ks1; } sr_[SDEPTH];
#define KTOK0(j) ((MODE == 0) ? 64 * (j) : (two ? ((64 * ((j) & 1)) * dil + ((j) >> 1)) : (ms + 64 * (j)) * dil))
#define KPOS0(j) (two ? (64 * ((j) & 1) + 4096 * ((j) >> 1)) : (ms + 64 * (j)))
#define SLOAD(i, j) do { const long tb_ = (long)__builtin_amdgcn_readfirstlane(KTOK0(j)) * ldk; const bf16* kt_ = Kh + tb_; const bf16* vt_ = Vh + tb_; \
    sr_[i].vs0 = *reinterpret_cast<const bf16x8*>(vt_ + lo0); sr_[i].vs1 = *reinterpret_cast<const bf16x8*>(vt_ + lo1); \
    sr_[i].ks0 = *reinterpret_cast<const bf16x8*>(kt_ + lo0); sr_[i].ks1 = *reinterpret_cast<const bf16x8*>(kt_ + lo1); } while (0)
#define SWRITE(b, i) do { *(bf16x8*)((char*)V_lds + (b) * SHM_V + vst0) = sr_[i].vs0;          \
    *(bf16x8*)((char*)V_lds + (b) * SHM_V + vst1) = sr_[i].vs1; int kc = sc * 2;               \
    *(bf16x8*)((char*)K_lds + (b) * SHM_K + KSWZ(sr, kc)) = sr_[i].ks0;                       \
    *(bf16x8*)((char*)K_lds + (b) * SHM_K + KSWZ(32 + sr, kc)) = sr_[i].ks1; } while (0)
#define SWAIT() do { if constexpr (SDEPTH == 2) asm volatile("s_waitcnt vmcnt(4)" ::: "memory"); else asm volatile("s_waitcnt vmcnt(0)" ::: "memory"); } while (0)
#define RESC(a) do { if (__any((a) < 1.f)) { if (hi == 0) al_l[r32] = (a); asm volatile("s_waitcnt lgkmcnt(0)" ::: "memory"); \
    for (int d = 0; d < 4; ++d) for (int r = 0; r < 16; ++r) o[d][r] *= al_l[crow(r, hi)]; } } while (0)
#define MASK(P0, P1, j) do { if (MODE == 1) band_mask(P0, P1, KPOS0(j) - qpos + 64, hi, biasL); } while (0)
  f32x16 pA0, pA1, pB0, pB1; float mnA, mnB, alA, alB; bf16x8 pa0, pa1, pa2, pa3;
  constexpr int SE = 0, SO = SDEPTH - 1;
  SLOAD(SE, 0); asm volatile("s_waitcnt vmcnt(0)" ::: "memory"); SWRITE(0, SE); __syncthreads();
  qkt(pA0, pA1, K_lds, qr, r32, hi); MASK(pA0, pA1, 0); partialSM(pA0, pA1, m_reg, mnA, alA);
  SLOAD(SO, 1); if constexpr (SDEPTH == 2) { if (2 < NT) SLOAD(SE, 2); }
  SWAIT(); SWRITE(1, SO); __syncthreads();
  for (int j = 1; j + 1 < NT; j += 2) {
    SBAR(); qkt(pB0, pB1, (bf16*)((char*)K_lds + SHM_K), qr, r32, hi);
    finishSM(pA0, pA1, alA, l_reg, pa0, pa1, pa2, pa3); SBAR();
    SLOAD(SO, j + SDEPTH); SBAR();
    pv_d0(o, vb0, pa0, pa1, pa2, pa3); MASK(pB0, pB1, j); partialSM(pB0, pB1, m_reg, mnB, alB);
    __syncthreads(); SWAIT(); SWRITE(0, SE);
    RESC(alB); __syncthreads();
    SBAR(); qkt(pA0, pA1, K_lds, qr, r32, hi);
    finishSM(pB0, pB1, alB, l_reg, pa0, pa1, pa2, pa3); SBAR();
    if (SDEPTH == 1 || j + 3 < NT) SLOAD(SE, j + 1 + SDEPTH); SBAR();
    pv_d0(o, vb0 + (int)SHM_V, pa0, pa1, pa2, pa3); MASK(pA0, pA1, j + 1); partialSM(pA0, pA1, m_reg, mnA, alA);
    __syncthreads(); SWAIT(); SWRITE(1, SO);
    RESC(alA); __syncthreads();
  }
  SBAR(); qkt(pB0, pB1, (bf16*)((char*)K_lds + SHM_K), qr, r32, hi);
  finishSM(pA0, pA1, alA, l_reg, pa0, pa1, pa2, pa3); SBAR();
  pv_d0(o, vb0, pa0, pa1, pa2, pa3); MASK(pB0, pB1, NT - 1); partialSM(pB0, pB1, m_reg, mnB, alB);
  __syncthreads(); RESC(alB);
  finishSM(pB0, pB1, alB, l_reg, pa0, pa1, pa2, pa3); SBAR();
  pv_d0(o, vb0 + (int)SHM_V, pa0, pa1, pa2, pa3);
  if (hi == 0) li_l[r32] = l_reg; asm volatile("s_waitcnt lgkmcnt(0)" ::: "memory");
  float rli[16];
#pragma unroll
  for (int r = 0; r < 16; ++r) rli[r] = __builtin_amdgcn_rcpf(li_l[crow(r, hi)]);
#pragma unroll
  for (int r = 0; r < 16; ++r) { const int qo = wid * QBLK + crow(r, hi);
    long ot = qo; if (MODE == 1) ot = two ? ((qo & 127) * dil + (qo >> 7)) : qo * dil;
    bf16* Ow = Oh + ot * LDO + r32;
#pragma unroll
    for (int d0 = 0; d0 < 4; ++d0) Ow[d0 * 32] = f2bf(o[d0][r] * rli[r]); }
  if (MODE == 1) { if (hi == 0) lse_o[(long)qt * 6] = m_reg * SCALE + logf(l_reg); }
#undef KTOK0
#undef KPOS0
#undef SLOAD
#undef SWRITE
#undef SWAIT
#undef RESC
#undef MASK
}

__device__ __forceinline__ void attn_unit_band(const bf16* __restrict__ Qh, const bf16* __restrict__ Kh, const bf16* __restrict__ Vh, bf16* __restrict__ Oh,
                                               float* __restrict__ lse_o, const int ldk, const int NT, const int dil, const int two, const int m0, const int ms,
                                               const float* __restrict__ bias_g, char* lds) {
  constexpr int LDQ = 4096, LDO = 2048;
  const int tid = threadIdx.x, wid = tid >> 6, lane = tid & 63, r32 = lane & 31, hi = lane >> 5;
  bf16* V_lds = (bf16*)lds; bf16* K_lds = (bf16*)(lds + 2 * SHM_V);
  float* ws = (float*)(lds + 2 * SHM_V + 2 * SHM_K) + wid * 64; float* li_l = ws; float* al_l = ws + 32;
  float* biasL = (float*)(lds + 2 * SHM_V + 2 * SHM_K + NW * 64 * 4);
  float m_reg = MINIT, l_reg = 0; f32x16 o[4] = {}; bf16x8 qr[8];
  const int qi = wid * QBLK + r32;
  const int qt = two ? ((qi & 127) * dil + (qi >> 7)) : qi * dil, qpos = two ? ((qi & 127) + 4096 * (qi >> 7)) : (m0 + qi);
  const bf16* Qw = Qh + (long)qt * LDQ + hi * 8;
#pragma unroll
  for (int d0 = 0; d0 < 8; ++d0) qr[d0] = *reinterpret_cast<const bf16x8*>(Qw + d0 * 16);
  if (tid < 129) {
    const int rel = (tid - 64) * dil, n = rel < 0 ? -rel : rel; const float nf = (float)(n > 1 ? n : 1);
    int large = 8 + (int)(logf(nf * 0.125f) / 4.852030263919617f * 8.0f); large = large < 15 ? large : 15;
    const int bucket = (rel > 0 ? 16 : 0) + (n < 8 ? n : large);
    biasL[tid] = bias_g[bucket * 6] * (1.0f / SCALE);
  }
  const int sr = tid >> 4, sc = (tid & 15) * 8, vst0 = v_st(sr, sc), vst1 = v_st(32 + sr, sc);
  const int vb0 = (int)(uintptr_t)V_lds + v_rd_base(lane);
  const unsigned lo0 = (unsigned)(sr * dil * ldk + sc), lo1 = lo0 + (unsigned)(32 * dil * ldk);
  bf16x8 vs0, vs1, ks0, ks1;
#define KTOK0(j) (two ? ((64 * ((j) & 1)) * dil + ((j) >> 1)) : (ms + 64 * (j)) * dil)
#define KPOS0(j) (two ? (64 * ((j) & 1) + 4096 * ((j) >> 1)) : (ms + 64 * (j)))
#define SLOAD(j) do { const long tb_ = (long)__builtin_amdgcn_readfirstlane(KTOK0(j)) * ldk; const bf16* kt_ = Kh + tb_; const bf16* vt_ = Vh + tb_; \
    vs0 = *reinterpret_cast<const bf16x8*>(vt_ + lo0); vs1 = *reinterpret_cast<const bf16x8*>(vt_ + lo1); \
    ks0 = *reinterpret_cast<const bf16x8*>(kt_ + lo0); ks1 = *reinterpret_cast<const bf16x8*>(kt_ + lo1); } while (0)
  const int qw0_ = wid * QBLK, qlo_w = __builtin_amdgcn_readfirstlane(two ? ((qw0_ & 127) + 4096 * (qw0_ >> 7)) : (m0 + qw0_)), qhi_w = qlo_w + 31;
  SLOAD(0);
  for (int j = 0; j < NT; ++j) {
    asm volatile("s_waitcnt vmcnt(0)" ::: "memory");
    __syncthreads();
    *(bf16x8*)((char*)V_lds + vst0) = vs0; *(bf16x8*)((char*)V_lds + vst1) = vs1;
    *(bf16x8*)((char*)K_lds + KSWZ(sr, sc * 2)) = ks0; *(bf16x8*)((char*)K_lds + KSWZ(32 + sr, sc * 2)) = ks1;
    __syncthreads();
    if (j + 1 < NT) SLOAD(j + 1);
    const int kp0_ = KPOS0(j);
    if (kp0_ > qhi_w + 64 || kp0_ + 63 < qlo_w - 64) continue;
    f32x16 p0, p1; float mn, al; bf16x8 pa0, pa1, pa2, pa3;
    SBAR(); qkt(p0, p1, K_lds, qr, r32, hi);
    band_mask(p0, p1, KPOS0(j) - qpos + 64, hi, biasL);
    partialSM(p0, p1, m_reg, mn, al);
    if (__any(al < 1.f)) { if (hi == 0) al_l[r32] = al; asm volatile("s_waitcnt lgkmcnt(0)" ::: "memory");
#pragma unroll
      for (int d = 0; d < 4; ++d)
#pragma unroll
        for (int r = 0; r < 16; ++r) o[d][r] *= al_l[crow(r, hi)]; }
    finishSM(p0, p1, al, l_reg, pa0, pa1, pa2, pa3); SBAR();
    pv_d0(o, vb0, pa0, pa1, pa2, pa3);
  }
  if (hi == 0) li_l[r32] = l_reg; asm volatile("s_waitcnt lgkmcnt(0)" ::: "memory");
  float rli[16];
#pragma unroll
  for (int r = 0; r < 16; ++r) rli[r] = __builtin_amdgcn_rcpf(li_l[crow(r, hi)]);
#pragma unroll
  for (int r = 0; r < 16; ++r) { const int qo = wid * QBLK + crow(r, hi);
    const long ot = two ? ((qo & 127) * dil + (qo >> 7)) : qo * dil;
    bf16* Ow = Oh + ot * LDO + r32;
#pragma unroll
    for (int d0 = 0; d0 < 4; ++d0) Ow[d0 * 32] = f2bf(o[d0][r] * rli[r]); }
  if (hi == 0) lse_o[(long)qt * 6] = m_reg * SCALE + logf(l_reg);
#undef KTOK0
#undef KPOS0
#undef SLOAD
}
#undef KSWZ
#undef SBAR
}
#define LAS __attribute__((address_space(3)))
#define XB_TMO      128
#define XB_XCNT(j)  (256  + 64 * (j))
#define XB_XSUB(j)  (1280 + 64 * (j))
#define XB_XGEN(j)  (2304 + 64 * (j))
#define XB_TOP      3328
#define XB_TOPGEN   3392
#define XCD_BAR_WORDS 3456
#define XB_SPIN_CAP (1u << 18)

__device__ __forceinline__ unsigned xb_ld(unsigned* p)              { return __hip_atomic_load(p, __ATOMIC_RELAXED, __HIP_MEMORY_SCOPE_AGENT); }
__device__ __forceinline__ unsigned xb_add(unsigned* p, unsigned v) { return __hip_atomic_fetch_add(p, v, __ATOMIC_RELAXED, __HIP_MEMORY_SCOPE_AGENT); }
__device__ __forceinline__ unsigned xb_xcc_id() { return (unsigned)__builtin_amdgcn_s_getreg((3 << 11) | 20) & 0xFu; }
#define XB_SPIN(cond, bar) do { unsigned _sp = 0; while (cond) { __builtin_amdgcn_s_sleep(1); \
    if ((++_sp & 255u) == 0u) { if (xb_ld(&(bar)[XB_TMO])) break; if (_sp > XB_SPIN_CAP) { atomicAdd(&(bar)[XB_TMO], 1u); break; } } } } while (0)

struct XcdBarrier {
    unsigned* bar; unsigned x;
    volatile LAS unsigned* st;
};

__device__ __forceinline__ XcdBarrier xcd_barrier_post(unsigned* bar, volatile LAS unsigned* st) {
    XcdBarrier b; b.bar = bar; b.x = xb_xcc_id(); b.st = st;
    if (threadIdx.x == 0) (void)xb_add(&bar[XB_XCNT(b.x)], 1u);
    return b;
}
__device__ __forceinline__ void xcd_barrier_complete(unsigned* bar, unsigned x, unsigned& nloc, unsigned& nx) {
    const unsigned G = gridDim.x * gridDim.y * gridDim.z;
    unsigned sum, cnt, mine, sp = 0u;
    for (;;) {
        sum = 0u; cnt = 0u; mine = 0u;
#pragma unroll
        for (unsigned j = 0; j < 16; ++j) { const unsigned c = xb_ld(&bar[XB_XCNT(j)]); sum += c; cnt += (c > 0u) ? 1u : 0u; mine = (j == x) ? c : mine; }
        if (sum == G) break;
        __builtin_amdgcn_s_sleep(1);
        if ((++sp & 255u) == 0u) { if (xb_ld(&bar[XB_TMO])) break; if (sp > XB_SPIN_CAP) { atomicAdd(&bar[XB_TMO], 1u); break; } }
    }
    nloc = mine > 0u ? mine : 1u; nx = cnt > 0u ? cnt : 1u;
}

__device__ __forceinline__ void xcd_barrier(const XcdBarrier& b) {
    asm volatile("s_waitcnt vmcnt(0)" ::: "memory");
    __syncthreads();
    if (threadIdx.x == 0) {
        unsigned* bar = b.bar;
        __builtin_amdgcn_s_waitcnt(0);
        unsigned nloc = b.st[0], nx = b.st[1];
        if (nloc == 0u) { xcd_barrier_complete(bar, b.x, nloc, nx); b.st[0] = nloc; b.st[1] = nx; }
        const unsigned old = xb_add(&bar[XB_XSUB(b.x)], 1u);
        const unsigned gen = old / nloc;
        if (old + 1u == (gen + 1u) * nloc) {
            __builtin_amdgcn_fence(__ATOMIC_RELEASE, "agent");
            asm volatile("s_waitcnt vmcnt(0)" ::: "memory");
            const unsigned og = xb_add(&bar[XB_TOP], 1u);
            const unsigned tg = og / nx;
            if (og + 1u == (tg + 1u) * nx) xb_add(&bar[XB_TOPGEN], 1u);
            else XB_SPIN(xb_ld(&bar[XB_TOPGEN]) == tg, bar);
            __builtin_amdgcn_fence(__ATOMIC_ACQUIRE, "agent");
            xb_add(&bar[XB_XGEN(b.x)], 1u);
            asm volatile("s_waitcnt vmcnt(0)" ::: "memory");
        } else {
            XB_SPIN(xb_ld(&bar[XB_XGEN(b.x)]) == gen, bar);
            __builtin_amdgcn_fence(__ATOMIC_ACQUIRE, "agent");
            asm volatile("s_waitcnt vmcnt(0)" ::: "memory");
        }
    }
    __syncthreads();
}
typedef unsigned short bf16;
typedef float f32x4 __attribute__((ext_vector_type(4)));
typedef unsigned u32x4 __attribute__((ext_vector_type(4)));
typedef float f32x2 __attribute__((ext_vector_type(2)));

constexpr int NWAVES = 8;
constexpr int DM = 2048, SEQ = 2048, NB_P = 4, NB_S = 16, NBATCH = NB_P + NB_S;
constexpr int TOK_P = NB_P * SEQ, TOK = NBATCH * SEQ;
constexpr int NMEM = 256, MEMROWS = NBATCH * NMEM;
constexpr int INC = 4096, DFF = 8192, MEMKV = 1024;
constexpr int C_QA = 0, C_KA = 768, C_VA = 1024, C_QB = 1280, C_KB = 2048, C_VB = 2816, C_QM = 3584;
constexpr float EPS = 1e-6f;

constexpr size_t MiB = 1u << 20;
constexpr size_t WS_ROPE = 1 * MiB;
constexpr size_t WS_WIN = 2 * MiB, WS_WMEM = 18 * MiB;
constexpr size_t WS_WOUT = 22 * MiB, WS_WUP = 30 * MiB, WS_WDOWN = 62 * MiB;
constexpr size_t WS_LSE = 94 * MiB;
constexpr size_t WS_KVM = 96 * MiB;
constexpr size_t WS_H = 112 * MiB, WS_MEMN = 272 * MiB;
constexpr size_t WS_U = 296 * MiB;
constexpr size_t WS_END = WS_U + (size_t)TOK * DFF * 2;
static_assert(WS_WMEM == WS_WIN + (size_t)INC * DM * 2 && WS_MEMN == WS_H + (size_t)TOK * DM * 2, "contiguous operands");
static_assert(WS_LSE + (size_t)TOK * 6 * 4 <= WS_KVM && WS_KVM + (size_t)MEMROWS * MEMKV * 2 <= WS_H && WS_MEMN + (size_t)MEMROWS * DM * 2 <= WS_U, "ws map");

constexpr int RING_BYTES = 131072;
constexpr int LDS_BYTES = 147456;
static_assert(att::SHM_ATTN <= RING_BYTES && pg8::STAGE_BYTES <= RING_BYTES, "LDS map");

__device__ __forceinline__ float wave_sum(float v) {
#pragma unroll
    for (int o = 1; o < 64; o <<= 1) v += __shfl_xor(v, o);
    return v;
}
__device__ __forceinline__ unsigned f2bf(float f) { unsigned u = __builtin_bit_cast(unsigned, f); return (u + 0x7fffu + ((u >> 16) & 1u)) >> 16; }
__device__ __forceinline__ unsigned pk2(float lo, float hi) { return f2bf(lo) | (f2bf(hi) << 16); }
__device__ __forceinline__ float bflo(unsigned w) { return __uint_as_float(w << 16); }
__device__ __forceinline__ float bfhi(unsigned w) { return __uint_as_float(w & 0xffff0000u); }
__device__ __forceinline__ u32x4 pack8(const f32x4 a, const f32x4 b) { u32x4 o; o.x = pk2(a.x, a.y); o.y = pk2(a.z, a.w); o.z = pk2(b.x, b.y); o.w = pk2(b.z, b.w); return o; }
__device__ __forceinline__ void unpack8(const u32x4 w, f32x4& a, f32x4& b) { a = (f32x4){bflo(w.x), bfhi(w.x), bflo(w.y), bfhi(w.y)}; b = (f32x4){bflo(w.z), bfhi(w.z), bflo(w.w), bfhi(w.w)}; }
__device__ __forceinline__ float sumsq4(const f32x4 a) { return (a.x * a.x + a.y * a.y) + (a.z * a.z + a.w * a.w); }

__device__ __forceinline__ void p0_transpose_item(const float* __restrict__ W, int K, int N, bf16* __restrict__ WT, LAS float* scr, int item, int lane) {
    const int nblk = N / 32, kb = item / nblk, nb = item % nblk, k0 = 64 * kb, n0 = 32 * nb;
#pragma unroll 8
    for (int i = 0; i < 32; ++i) { const int kk = 2 * i + (lane >> 5); scr[kk * 33 + (lane & 31)] = W[(size_t)(k0 + kk) * N + n0 + (lane & 31)]; }
    asm volatile("s_waitcnt lgkmcnt(0)" ::: "memory");
    const int c = lane & 7;
#pragma unroll
    for (int j = 0; j < 4; ++j) { const int n = (lane >> 3) + 8 * j; const LAS float* s = scr + (8 * c) * 33 + n;
        u32x4 o; o.x = pk2(s[0 * 33], s[1 * 33]); o.y = pk2(s[2 * 33], s[3 * 33]); o.z = pk2(s[4 * 33], s[5 * 33]); o.w = pk2(s[6 * 33], s[7 * 33]);
        *(u32x4*)(WT + (size_t)(n0 + n) * K + k0 + 8 * c) = o; }
    asm volatile("s_waitcnt lgkmcnt(0)" ::: "memory");
}

__device__ __forceinline__ void rms_row_to_bf16(const float* __restrict__ src, const float* __restrict__ g, bf16* __restrict__ dst, int lane) {
    f32x4 v[4][2]; float ss = 0.f;
#pragma unroll
    for (int j = 0; j < 4; ++j) { const float* p = src + 8 * (lane + 64 * j); v[j][0] = *(const f32x4*)p; v[j][1] = *(const f32x4*)(p + 4); ss += sumsq4(v[j][0]) + sumsq4(v[j][1]); }
    const float rstd = 1.0f / sqrtf(wave_sum(ss) * (1.0f / DM) + EPS);
#pragma unroll
    for (int j = 0; j < 4; ++j) { const int c = 8 * (lane + 64 * j); const f32x4 g0 = *(const f32x4*)(g + c), g1 = *(const f32x4*)(g + c + 4);
        *(u32x4*)(dst + c) = pack8(v[j][0] * rstd * g0, v[j][1] * rstd * g1); }
}

__device__ __forceinline__ unsigned long long ld_ptr(volatile LAS unsigned long long* PT, int k) { const unsigned long long v = PT[k];
    const unsigned lo = __builtin_amdgcn_readfirstlane((unsigned)v), hi = __builtin_amdgcn_readfirstlane((unsigned)(v >> 32)); return ((unsigned long long)hi << 32) | lo; }
struct Args { const float* in[20]; float* out; unsigned char* ws; int ph_lo, ph_hi; };
constexpr int N_PHASES = 10;

__global__ void __launch_bounds__(NWAVES * 64, 2) mk_fwd(Args args) {
    extern __shared__ __attribute__((aligned(16))) unsigned char lds[];
    cg::grid_group grid = cg::this_grid();
    const int tid = threadIdx.x, lane = tid & 63, wave = __builtin_amdgcn_readfirstlane(tid >> 6);
    const int G = gridDim.x, bid = blockIdx.x;
    const int gw = bid * NWAVES + wave, NGW = G * NWAVES;
    unsigned char* ws = args.ws;
    float* out = args.out;
    f32x2* ROPE = (f32x2*)(ws + WS_ROPE);
    bf16* WIN = (bf16*)(ws + WS_WIN); bf16* WMEM = (bf16*)(ws + WS_WMEM); bf16* WOUT = (bf16*)(ws + WS_WOUT); bf16* WUP = (bf16*)(ws + WS_WUP); bf16* WDOWN = (bf16*)(ws + WS_WDOWN);
    float* LSE = (float*)(ws + WS_LSE); bf16* KVM = (bf16*)(ws + WS_KVM); bf16* H = (bf16*)(ws + WS_H); bf16* U = (bf16*)(ws + WS_U);
    bf16* QKV = U; bf16* Y3 = U; bf16* MIX = H; bf16* H2 = H; bf16* Y5 = H;
    LAS unsigned char* ldsl = (LAS unsigned char*)lds;
    const int lo = args.ph_lo, hi = args.ph_hi;
    volatile LAS unsigned* MISC = (volatile LAS unsigned*)(ldsl + RING_BYTES);
    if (tid < 64) MISC[tid] = 0u;
    volatile LAS unsigned long long* PT = (volatile LAS unsigned long long*)(ldsl + RING_BYTES + 512);
    if (tid == 0) {
        PT[0] = (unsigned long long)args.in[0]; PT[1] = (unsigned long long)args.in[1]; PT[2] = (unsigned long long)args.in[2]; PT[3] = (unsigned long long)args.in[3]; PT[4] = (unsigned long long)args.in[4];
        PT[5] = (unsigned long long)args.in[5]; PT[6] = (unsigned long long)args.in[6]; PT[7] = (unsigned long long)args.in[7]; PT[8] = (unsigned long long)args.in[8]; PT[9] = (unsigned long long)args.in[9];
        PT[10] = (unsigned long long)args.in[10]; PT[11] = (unsigned long long)args.in[11]; PT[12] = (unsigned long long)args.in[12]; PT[13] = (unsigned long long)args.in[13]; PT[14] = (unsigned long long)args.in[14];
        PT[15] = (unsigned long long)args.in[15]; PT[16] = (unsigned long long)args.in[16]; PT[17] = (unsigned long long)args.in[17]; PT[18] = (unsigned long long)args.in[18]; PT[19] = (unsigned long long)args.in[19];
    }
    __syncthreads();
#define INP(k) ((const float*)ld_ptr(PT, (k)))
    XcdBarrier xbar; xbar.bar = (unsigned*)ws; xbar.x = 0; xbar.st = MISC + 8;
    if (hi - lo > 1) xbar = xcd_barrier_post((unsigned*)ws, MISC + 8);
#define IN(k) (lo <= (k) && (k) < hi)
#ifndef REP_SYNC
#define REP_SYNC 1
#endif
#define SEAM(k) do { if (IN(k) && IN((k) + 1)) { for (int s_ = 0; s_ < REP_SYNC; ++s_) { if ((k) == 0) grid.sync(); else xcd_barrier(xbar); } } } while (0)
#define XROW(m) ((m) < TOK_P ? x_p + (size_t)(m) * DM : x_s + (size_t)((m) - TOK_P) * DM)

    if (IN(0)) {
        const float* x_p = INP(0); const float* x_s = INP(1); const float* mem_p = INP(2); const float* mem_s = INP(3); const float* g_premix = INP(5); const float* w_in = INP(6);
        const float* g_mem = INP(9); const float* w_mem = INP(10); const float* w_out = INP(14); const float* w_up = INP(17); const float* w_down = INP(18);
        LAS float* scr = (LAS float*)(ldsl + wave * 16384);
        constexpr int I_IN = (DM / 64) * (INC / 32), I_MEM = (DM / 64) * (MEMKV / 32), I_OUT = (DM / 64) * (DM / 32), I_UP = (DM / 64) * (DFF / 32), I_DN = (DFF / 64) * (DM / 32);
        constexpr int NITEMS = I_IN + I_MEM + I_OUT + I_UP + I_DN;
        for (int it = gw; it < NITEMS; it += NGW) {
            int r = it;
            if (r < I_IN) { p0_transpose_item(w_in, DM, INC, WIN, scr, r, lane); continue; } r -= I_IN;
            if (r < I_MEM) { p0_transpose_item(w_mem, DM, MEMKV, WMEM, scr, r, lane); continue; } r -= I_MEM;
            if (r < I_OUT) { p0_transpose_item(w_out, DM, DM, WOUT, scr, r, lane); continue; } r -= I_OUT;
            if (r < I_UP) { p0_transpose_item(w_up, DM, DFF, WUP, scr, r, lane); continue; } r -= I_UP;
            p0_transpose_item(w_down, DFF, DM, WDOWN, scr, r, lane);
        }
        { const int gt = bid * (NWAVES * 64) + tid; if (gt < 64 * 32) { const int pos = gt >> 5, j = gt & 31; const float inv = powf(10000.0f, -(2.0f * (float)j) / 64.0f); const float ang = (float)pos * inv;
            ROPE[gt] = (f32x2){cosf(ang), sinf(ang)}; } }
        for (int m = gw; m < TOK + MEMROWS; m += NGW) {
            const float* src; const float* g = g_premix;
            if (m < TOK) src = XROW(m);
            else { const int mm = m - TOK; g = g_mem; src = mm < NB_P * NMEM ? mem_p + (size_t)mm * DM : mem_s + (size_t)(mm - NB_P * NMEM) * DM; }
            rms_row_to_bf16(src, g, H + (size_t)m * DM, lane);
        }
    }
    SEAM(0);

    if (IN(1)) {
        pg8::Gemm g{H, WIN, TOK, INC, DM}; pg8::StaticOrder S; S.init(TOK, INC, G, bid);
        pg8::EpiOut<0, false> E{QKV, INC, nullptr, 0};
        pg8::gemm_phase<pg8::EpiOut<0, false>, pg8::StaticOrder, true, true>(ldsl, g, S, E);
    }
    SEAM(1);

    if (IN(2)) {
        const float* g_qn = INP(7); const float* g_kn = INP(8);
        const int half = lane >> 5, j = lane & 31;
        const float gq1 = g_qn[64 * half + j], gq2 = g_qn[64 * half + j + 32], gk1 = g_kn[64 * half + j], gk2 = g_kn[64 * half + j + 32];
        for (int t = gw; t < TOK; t += NGW) {
            const int s = t & (SEQ - 1); const int pos = half ? (s & 63) : (s >> 6);
            const f32x2 cs = ROPE[pos * 32 + j];
            bf16* row = QKV + (size_t)t * INC + 64 * half + j;
#pragma unroll
            for (int h8 = 0; h8 < 8; ++h8) {
                const float x1 = bflo((unsigned)row[h8 * 128]), x2 = bflo((unsigned)row[h8 * 128 + 32]);
                const float rstd = 1.0f / sqrtf(wave_sum(x1 * x1 + x2 * x2) * (1.0f / 128.0f) + EPS);
                const float a1 = x1 * rstd * (h8 < 6 ? gq1 : gk1), a2 = x2 * rstd * (h8 < 6 ? gq2 : gk2);
                row[h8 * 128] = (bf16)f2bf(a1 * cs.x - a2 * cs.y); row[h8 * 128 + 32] = (bf16)f2bf(a2 * cs.x + a1 * cs.y);
            }
        }
    }
    SEAM(2);

    if (IN(3)) {
        const float* rel_bias = INP(4);
        constexpr int NA = NBATCH * 6 * 8, NBU = NBATCH * 6 * 8, NMU = NBATCH * 4 * 8, NMEMU = (MEMROWS / 256) * (MEMKV / 256);
        unsigned* ctl = (unsigned*)ws;
        unsigned* qA = ctl + 4096, * qB = ctl + 4096 + 64, * qM = ctl + 4096 + 128, * kvm_rdy = ctl + 4096 + 192;
        volatile LAS unsigned* qslot = MISC + 16;
        { const int nG = G < NMEMU ? G : NMEMU;
          if (bid >= G - nG) {
            pg8::Gemm g{H, WIN, TOK + MEMROWS, INC + MEMKV, DM}; pg8::ExtraOnly S; S.e0 = bid - (G - nG); S.step = nG; S.n = NMEMU;
            pg8::EpiOut<0, true> E{QKV, INC, KVM, MEMKV};
            pg8::gemm_phase<pg8::EpiOut<0, true>, pg8::ExtraOnly, true, true>(ldsl, g, S, E);
            if (tid == 0) { unsigned mine = 0; for (int e = S.e0; e < NMEMU; e += nG) ++mine;
                __builtin_amdgcn_fence(__ATOMIC_RELEASE, "agent"); asm volatile("s_waitcnt vmcnt(0)" ::: "memory");
                __hip_atomic_fetch_add(kvm_rdy, mine, __ATOMIC_RELAXED, __HIP_MEMORY_SCOPE_AGENT); }
          } }
        const bool deal = (G == 256);
        const int cls = !deal ? 3 : (bid < 176 ? 0 : (bid < 192 ? 1 : 2));
        const int nA_mine = !deal ? (NA - bid + G - 1) / G : (cls == 2 ? 3 : 4);
        const int nS_mine = !deal ? (NBU + NMU - bid + G - 1) / G : (cls == 0 ? 6 : (cls == 1 ? 2 : 8));
#define A_IDX(i) (!deal ? bid + (i) * G : (cls == 0 ? bid + 176 * (i) : ((i) < 3 ? 704 + (bid - 176) + 80 * (i) : 944 + (bid - 176))))
#define S_IDX(i) (!deal ? bid + (i) * G : (cls == 0 ? bid + 176 * (i) : (cls == 1 ? 1056 + (bid - 176) + 16 * (i) : 1088 + (bid - 192) + 64 * (i))))
        for (int i = 0; i < nA_mine * REP_ATTN; ++i) { const int u = A_IDX(i % nA_mine);
            const int qb = u & 7, hq = (u >> 3) % 6, b = u / 48; const size_t r0 = (size_t)b * SEQ;
            att::attn_unit<0>(QKV + (r0 + qb * 256) * INC + C_QA + hq * 128, QKV + r0 * INC + C_KA + (hq / 3) * 128, QKV + r0 * INC + C_VA + (hq / 3) * 128,
                              MIX + (r0 + qb * 256) * DM + hq * 128, nullptr, INC, SEQ / 64, 1, 0, 0, 0, nullptr, (char*)lds);
        }
        __syncthreads();
        for (int i = 0; i < nS_mine * REP_ATTN; ++i) { const int v = S_IDX(i % nS_mine); if (v >= NBU) continue;
            const int chunk = v & 7, head = (v >> 3) % 6, b = v / 48, gi = head >> 1; const size_t r0 = (size_t)b * SEQ;
            int dil, two, m0, ms, c, NT;
            if (gi == 0) { dil = 1; two = 0; c = 0; m0 = 256 * chunk; NT = 6; ms = min(max(m0 - 64, 0), SEQ - 384); }
            else if (gi == 1) { dil = 4; two = 0; c = chunk >> 1; m0 = 256 * (chunk & 1); NT = 6; ms = min(max(m0 - 64, 0), SEQ / 4 - 384); }
            else { dil = 16; two = 1; c = 2 * chunk; m0 = 0; ms = 0; NT = 4; }
            const size_t rq = r0 + c + (size_t)m0 * dil, rk = r0 + c;
            att::attn_unit_band(QKV + rq * INC + C_QB + head * 128, QKV + rk * INC + C_KB + head * 128, QKV + rk * INC + C_VB + head * 128,
                                MIX + rq * DM + 768 + head * 128, LSE + rq * 6 + head, INC, NT, dil, two, m0, ms, rel_bias + head, (char*)lds);
        }
        __syncthreads();
        if (tid == 0) { unsigned sp = 0; while (__hip_atomic_load(kvm_rdy, __ATOMIC_RELAXED, __HIP_MEMORY_SCOPE_AGENT) < (unsigned)NMEMU) { __builtin_amdgcn_s_sleep(2); if (++sp > (1u << 22)) break; }
            __builtin_amdgcn_fence(__ATOMIC_ACQUIRE, "agent"); asm volatile("s_waitcnt vmcnt(0)" ::: "memory"); }
        __syncthreads();
        for (int i = 0; i < nS_mine * REP_ATTN; ++i) { const int v = S_IDX(i % nS_mine) - NBU; if (v < 0) continue;
            const int qb = v & 7, hm = (v >> 3) & 3, b = v >> 5; const size_t r0 = (size_t)b * SEQ;
            att::attn_unit<0>(QKV + (r0 + qb * 256) * INC + C_QM + hm * 128, KVM + (size_t)b * NMEM * MEMKV + hm * 128, KVM + (size_t)b * NMEM * MEMKV + 512 + hm * 128,
                              MIX + (r0 + qb * 256) * DM + 1536 + hm * 128, nullptr, MEMKV, NMEM / 64, 1, 0, 0, 0, nullptr, (char*)lds);
        }
#undef A_IDX
#undef S_IDX
    }
    SEAM(3);

    if (IN(4)) {
        const float* g_oa = INP(11); const float* g_ob = INP(12); const float* g_om = INP(13);
        for (int t = gw; t < TOK; t += NGW) {
            bf16* row = MIX + (size_t)t * DM; const float* ls = LSE + (size_t)t * 6;
            float al[6];
            { float l[6];
#pragma unroll
              for (int i = 0; i < 6; ++i) l[i] = ls[i];
#pragma unroll
              for (int hp = 0; hp < 2; ++hp) { const float mx = fmaxf(fmaxf(l[hp], l[2 + hp]), l[4 + hp]);
                const float e0 = __expf(l[hp] - mx), e1 = __expf(l[2 + hp] - mx), e2 = __expf(l[4 + hp] - mx), inv = 1.0f / (e0 + e1 + e2);
                al[hp] = e0 * inv; al[2 + hp] = e1 * inv; al[4 + hp] = e2 * inv; } }
            f32x4 v[4][2]; float ssA = 0.f, ssB = 0.f, ssM = 0.f;
#pragma unroll
            for (int j = 0; j < 4; ++j) { const int c = 8 * (lane + 64 * j); unpack8(*(const u32x4*)(row + c), v[j][0], v[j][1]);
                const int seg = c < 768 ? 0 : (c < 1536 ? 1 : 2);
                if (seg == 1) { const int hb = (c - 768) >> 7; float a = al[0];
#pragma unroll
                    for (int i = 1; i < 6; ++i) a = (hb == i) ? al[i] : a;
                    v[j][0] = v[j][0] * a; v[j][1] = v[j][1] * a; }
                const float q = sumsq4(v[j][0]) + sumsq4(v[j][1]);
                ssA += seg == 0 ? q : 0.f; ssB += seg == 1 ? q : 0.f; ssM += seg == 2 ? q : 0.f; }
            const float rA = 1.0f / sqrtf(wave_sum(ssA) * (1.0f / 768.0f) + EPS), rB = 1.0f / sqrtf(wave_sum(ssB) * (1.0f / 768.0f) + EPS), rM = 1.0f / sqrtf(wave_sum(ssM) * (1.0f / 512.0f) + EPS);
#pragma unroll
            for (int j = 0; j < 4; ++j) { const int c = 8 * (lane + 64 * j); const int seg = c < 768 ? 0 : (c < 1536 ? 1 : 2);
                const float* gp = seg == 0 ? g_oa + c : (seg == 1 ? g_ob + (c - 768) : g_om + (c - 1536)); const float r = seg == 0 ? rA : (seg == 1 ? rB : rM);
                const f32x4 g0 = *(const f32x4*)gp, g1 = *(const f32x4*)(gp + 4);
                *(u32x4*)(row + c) = pack8(v[j][0] * r * g0, v[j][1] * r * g1); }
        }
    }
    SEAM(4);

    if (IN(5)) {
        pg8::Gemm g{MIX, WOUT, TOK, DM, DM}; pg8::StaticOrder S; S.init(TOK, DM, G, bid);
        pg8::EpiOut<0, false> E{Y3, DM, nullptr, 0};
        pg8::gemm_phase<pg8::EpiOut<0, false>, pg8::StaticOrder, true, true>(ldsl, g, S, E);
    }
    SEAM(5);

    if (IN(6)) {
        const float* x_p = INP(0); const float* x_s = INP(1); const float* g_postmix = INP(15); const float* g_preffn = INP(16);
        for (int t = gw; t < TOK; t += NGW) {
            const float* xr = XROW(t); const bf16* yr = Y3 + (size_t)t * DM; float* orow = out + (size_t)t * DM;
            f32x4 v[4][2]; float ss = 0.f;
#pragma unroll
            for (int j = 0; j < 4; ++j) { const int c = 8 * (lane + 64 * j); unpack8(*(const u32x4*)(yr + c), v[j][0], v[j][1]); ss += sumsq4(v[j][0]) + sumsq4(v[j][1]); }
            const float r3 = 1.0f / sqrtf(wave_sum(ss) * (1.0f / DM) + EPS); float s1 = 0.f;
#pragma unroll
            for (int j = 0; j < 4; ++j) { const int c = 8 * (lane + 64 * j);
                const f32x4 g0 = *(const f32x4*)(g_postmix + c), g1 = *(const f32x4*)(g_postmix + c + 4), x0 = *(const f32x4*)(xr + c), x1 = *(const f32x4*)(xr + c + 4);
                v[j][0] = x0 + v[j][0] * r3 * g0; v[j][1] = x1 + v[j][1] * r3 * g1;
                *(f32x4*)(orow + c) = v[j][0]; *(f32x4*)(orow + c + 4) = v[j][1]; s1 += sumsq4(v[j][0]) + sumsq4(v[j][1]); }
            const float r1 = 1.0f / sqrtf(wave_sum(s1) * (1.0f / DM) + EPS);
#pragma unroll
            for (int j = 0; j < 4; ++j) { const int c = 8 * (lane + 64 * j); const f32x4 g0 = *(const f32x4*)(g_preffn + c), g1 = *(const f32x4*)(g_preffn + c + 4);
                *(u32x4*)(H2 + (size_t)t * DM + c) = pack8(v[j][0] * r1 * g0, v[j][1] * r1 * g1); }
        }
    }
    SEAM(6);

    if (IN(7)) {
        pg8::Gemm g{H2, WUP, TOK, DFF, DM}; pg8::StaticOrder S; S.init(TOK, DFF, G, bid);
        pg8::EpiOut<2, false> E{U, DFF, nullptr, 0};
        pg8::gemm_phase<pg8::EpiOut<2, false>, pg8::StaticOrder, true, true>(ldsl, g, S, E);
    }
    SEAM(7);

    if (IN(8)) {
        pg8::Gemm g{U, WDOWN, TOK, DM, DFF}; pg8::StaticOrder S; S.init(TOK, DM, G, bid);
        pg8::EpiOut<0, false> E{Y5, DM, nullptr, 0};
        pg8::gemm_phase<pg8::EpiOut<0, false>, pg8::StaticOrder, true, true>(ldsl, g, S, E);
    }
    SEAM(8);

    if (IN(9)) {
        const float* g_postffn = INP(19);
        for (int t = gw; t < TOK; t += NGW) {
            const bf16* yr = Y5 + (size_t)t * DM; float* orow = out + (size_t)t * DM;
            f32x4 v[4][2]; float ss = 0.f;
#pragma unroll
            for (int j = 0; j < 4; ++j) { const int c = 8 * (lane + 64 * j); unpack8(*(const u32x4*)(yr + c), v[j][0], v[j][1]); ss += sumsq4(v[j][0]) + sumsq4(v[j][1]); }
            const float r5 = 1.0f / sqrtf(wave_sum(ss) * (1.0f / DM) + EPS);
#pragma unroll
            for (int j = 0; j < 4; ++j) { const int c = 8 * (lane + 64 * j);
                const f32x4 g0 = *(const f32x4*)(g_postffn + c), g1 = *(const f32x4*)(g_postffn + c + 4), x0 = *(const f32x4*)(orow + c), x1 = *(const f32x4*)(orow + c + 4);
                *(f32x4*)(orow + c) = x0 + v[j][0] * r5 * g0; *(f32x4*)(orow + c + 4) = x1 + v[j][1] * r5 * g1; }
        }
    }
#undef IN
#undef SEAM
#undef XROW
}

#ifndef MK_N_LAUNCHES
#define MK_N_LAUNCHES 1
#endif
extern "C" void kernel_launch(void* const* d_in, const int* in_sizes, int n_in, void* d_out, int out_size, void* d_ws, size_t ws_size, hipStream_t stream) {
    static int grid = 0;
    if (grid == 0) {
        if (n_in != 20 || in_sizes[0] != TOK_P * DM || in_sizes[1] != (TOK - TOK_P) * DM || out_size != TOK * DM || ws_size < WS_END) {
            fprintf(stderr, "kernel_launch: shape mismatch: n_in %d in0 %d in1 %d out %d ws %zu (need %zu); nothing launched\n", n_in, n_in > 0 ? in_sizes[0] : -1, n_in > 1 ? in_sizes[1] : -1, out_size, ws_size, (size_t)WS_END);
            grid = -1; return; }
        int dev = 0, cus = 0, per_cu = 0;
        if (hipGetDevice(&dev) != hipSuccess || hipDeviceGetAttribute(&cus, hipDeviceAttributeMultiprocessorCount, dev) != hipSuccess) { fprintf(stderr, "kernel_launch: device query failed\n"); grid = -1; return; }
        if (hipFuncSetAttribute((const void*)mk_fwd, hipFuncAttributeMaxDynamicSharedMemorySize, LDS_BYTES) != hipSuccess) { fprintf(stderr, "kernel_launch: hipFuncSetAttribute failed\n"); grid = -1; return; }
        if (hipOccupancyMaxActiveBlocksPerMultiprocessor(&per_cu, (const void*)mk_fwd, NWAVES * 64, LDS_BYTES) != hipSuccess || per_cu < 1) { fprintf(stderr, "kernel_launch: occupancy query says %d\n", per_cu); per_cu = 1; }
        (void)hipGetLastError();
        grid = cus * per_cu;
    }
    if (grid < 0) return;
    if (hipMemsetAsync(d_ws, 0, 32768, stream) != hipSuccess) { fprintf(stderr, "kernel_launch: memset failed\n"); return; }
    Args a{};
    for (int i = 0; i < 20; ++i) a.in[i] = (const float*)d_in[i];
    a.out = (float*)d_out; a.ws = (unsigned char*)d_ws;
#if MK_N_LAUNCHES == 1
    a.ph_lo = 0; a.ph_hi = N_PHASES;
    void* kargs[] = {&a};
    const hipError_t e = hipLaunchCooperativeKernel((const void*)mk_fwd, dim3(grid), dim3(NWAVES * 64), kargs, LDS_BYTES, stream);
    if (e != hipSuccess) fprintf(stderr, "kernel_launch: cooperative launch failed: %s (grid %d)\n", hipGetErrorString(e), grid);
#else
    for (int p = 0; p < N_PHASES; ++p) { a.ph_lo = p; a.ph_hi = p + 1; hipLaunchKernelGGL(mk_fwd, dim3(grid), dim3(NWAVES * 64), LDS_BYTES, stream, a); }
#endif
}
```

```cpp
#include <hip/hip_runtime.h>
#include <hip/hip_cooperative_groups.h>
#include <cstdio>
#include <cstdint>
namespace cg = cooperative_groups;
#ifndef REP_GEMM
#define REP_GEMM 1
#endif
#ifndef REP_ATTN
#define REP_ATTN 1
#endif
#ifndef REP_ROW
#define REP_ROW 1
#endif
namespace pg8 {
#define PG8_LAS __attribute__((address_space(3)))
typedef unsigned short bf16_t;
typedef short bf16x8 __attribute__((ext_vector_type(8)));
typedef float f32x4 __attribute__((ext_vector_type(4)));
typedef unsigned u32x4 __attribute__((ext_vector_type(4)));
constexpr int BM = 256, BK = 64, HALF = 128, HTB = HALF * BK * 2  , STAGE_BYTES = 8 * HTB, NXCD = 8, WGM = 8;

__host__ __device__ __forceinline__ int lds_byte(int r, int c) { const int st = (r >> 4) * 2 + (c >> 5), rr = r & 15, cc = c & 31, ob = rr * 64 + cc * 2; return st * 1024 + (ob ^ (((ob >> 9) & 1) << 5)); }
__host__ __device__ __forceinline__ void stage_rc(int b, int& R, int& C) { const int st = b / 1024, sb = b % 1024, swz = sb ^ (((sb >> 9) & 1) << 5); R = (st >> 1) * 16 + swz / 64; C = (st & 1) * 32 + (swz % 64) / 2; }
__host__ __device__ __forceinline__ int perm32(int rho) { const int n = rho >> 4, i = rho & 15; return 8 * (i >> 2) + 4 * n + (i & 3); }

struct Unit { int pm, pn; };
struct Gemm { const bf16_t* A; const bf16_t* Bt; int M, N, K; };

struct StaticOrder {
    int nM, nN, nwg, G, c;
    __host__ __device__ void init(int M, int N, int G_, int c_) { nM = M / BM; nN = N / BM; nwg = nM * nN; G = G_; c = c_; }
    __host__ __device__ bool next(int i, Unit& u) const {
#if REP_GEMM > 1
        { const int per = nwg / G; if (i >= per * REP_GEMM) return false; i = i % per; }
#endif
        const long L = (long)i * G + c; if (L >= nwg) return false;
        int wgid = (int)L; { const int q = nwg / NXCD, r = nwg % NXCD, xcd = wgid % NXCD, off = wgid / NXCD; wgid = (xcd < r ? xcd * (q + 1) : r * (q + 1) + (xcd - r) * q) + off; }
        const int nig = WGM * nN, gid = wgid / nig, fm = gid * WGM, gsz = (nM - fm) < WGM ? (nM - fm) : WGM;
        u.pm = fm + ((wgid % nig) % gsz); u.pn = (wgid % nig) / gsz; return true;
    }
    __device__ __forceinline__ void a_ready(const Unit&) const {}
    __device__ __forceinline__ void done(const Unit&) const {}
};

__device__ __forceinline__ unsigned cvt_pk_bf16(float lo, float hi) { unsigned r; asm volatile("v_cvt_pk_bf16_f32 %0, %1, %2" : "=v"(r) : "v"(lo), "v"(hi)); return r; }
typedef float f32x2 __attribute__((ext_vector_type(2)));
template <int ACT, bool MEMSPLIT> struct EpiOut {
    static constexpr bool PERM = true, AFTER_DRAIN = false;
    static constexpr int SPLIT_PM = 160, SPLIT_PN = 16;
    bf16_t* O; int ldc; bf16_t* O2; int ldc2;
    __device__ __forceinline__ void operator()(const f32x4 (&acc)[2][2][4][2], const Unit& u, int wr, int wc, int fr, int fq) const {
        int row0 = u.pm * BM + wr * 64 + fr; int colt = u.pn * BM; bf16_t* base = O; int ld = ldc;
        if (MEMSPLIT) { if (u.pm >= SPLIT_PM) { base = O2; ld = ldc2; row0 -= SPLIT_PM * BM; colt -= SPLIT_PN * BM; } }
        const int col0 = colt + wc * 32 + 8 * fq;
#pragma unroll
        for (int ai = 0; ai < 2; ++ai)
#pragma unroll
            for (int m = 0; m < 4; ++m) { bf16_t* rowp = base + (size_t)(row0 + ai * HALF + m * 16) * ld + col0;
#pragma unroll
                for (int bj = 0; bj < 2; ++bj) { f32x4 v0 = acc[ai][bj][m][0], v1 = acc[ai][bj][m][1];
                    if (ACT == 2) {
#pragma unroll
                        for (int e = 0; e < 4; ++e) { const float a = fmaxf(v0[e], 0.f), b = fmaxf(v1[e], 0.f); v0[e] = a * a; v1[e] = b * b; } }
                    u32x4 w; w.x = cvt_pk_bf16(v0[0], v0[1]); w.y = cvt_pk_bf16(v0[2], v0[3]); w.z = cvt_pk_bf16(v1[0], v1[1]); w.w = cvt_pk_bf16(v1[2], v1[3]);
                    *(u32x4*)(rowp + bj * HALF) = w; } }
    }
};
struct OrderWithMem {
    StaticOrder so; int nextra;
    __host__ __device__ bool next(int i, Unit& u) const {
#if REP_GEMM > 1
        const int per = so.nwg / so.G; if (i < per * REP_GEMM) return so.next(i, u);
        const long L = (long)(i - per * (REP_GEMM - 1)) * so.G + so.c;
#else
        const long L = (long)i * so.G + so.c; if (L < so.nwg) return so.next(i, u);
#endif
        const int e = (int)(L - so.nwg); if (e >= nextra) return false;
        u.pm = 160 + e % 20; u.pn = 16 + e / 20; return true;
    }
    __device__ __forceinline__ void a_ready(const Unit&) const {}
    __device__ __forceinline__ void done(const Unit&) const {}
};

struct ExtraOnly {
    int e0, step, n;
    __host__ __device__ bool next(int i, Unit& u) const { const int e = e0 + i * step; if (e >= n) return false; u.pm = 160 + e % 20; u.pn = 16 + e / 20; return true; }
    __device__ __forceinline__ void a_ready(const Unit&) const {}
    __device__ __forceinline__ void done(const Unit&) const {}
};

struct PanelRound {
    int r, c;
    __host__ __device__ bool next(int i, Unit& u) const { if (i > 0) return false; const int x = c & 7, j = c >> 3; u.pm = r * 32 + x * 4 + (j & 3); u.pn = j >> 2; return true; }
    __device__ __forceinline__ void a_ready(const Unit&) const {}
    __device__ __forceinline__ void done(const Unit&) const {}
};
struct RowSsq {
    unsigned* slots;
    unsigned* cnt;
    float inv_n, eps;
    __device__ __forceinline__ void run(const f32x4 (&v)[2][2][4][2], const Unit& u, int wr, int wc, int fr, int fq, PG8_LAS unsigned char* lds, int wid, int lane) const {
        PG8_LAS float* P = (PG8_LAS float*)lds;
        PG8_LAS float* S = (PG8_LAS float*)(lds + 8192);
#pragma unroll
        for (int ai = 0; ai < 2; ++ai)
#pragma unroll
            for (int m = 0; m < 4; ++m) {
                float s = 0.f;
#pragma unroll
                for (int bj = 0; bj < 2; ++bj)
#pragma unroll
                    for (int n = 0; n < 2; ++n) { const f32x4 x = v[ai][bj][m][n]; s += (x[0] * x[0] + x[1] * x[1]) + (x[2] * x[2] + x[3] * x[3]); }
                s += __shfl_xor(s, 16); s += __shfl_xor(s, 32);
                if (fq == 0) P[(ai * HALF + wr * 64 + m * 16 + fr) * 4 + wc] = s;
            }
        asm volatile("s_waitcnt lgkmcnt(0)" ::: "memory"); __builtin_amdgcn_s_barrier(); asm volatile("" ::: "memory");
        const int row = wid * 32 + (lane & 31);
        if (lane < 32) {
            const float tot = (P[row * 4 + 0] + P[row * 4 + 1]) + (P[row * 4 + 2] + P[row * 4 + 3]);
            __hip_atomic_store(slots + ((size_t)(u.pm * BM + row) * 8 + u.pn), __float_as_uint(tot), __ATOMIC_RELAXED, __HIP_MEMORY_SCOPE_AGENT);
        }
        asm volatile("s_waitcnt vmcnt(0)" ::: "memory");
        if (lane == 0) __hip_atomic_fetch_add(cnt + 64 * u.pm, 1u, __ATOMIC_RELAXED, __HIP_MEMORY_SCOPE_AGENT);
        if (wid == 0) {
            const unsigned long long t0 = __builtin_amdgcn_s_memrealtime();
            for (;;) {
                if ((unsigned)__builtin_amdgcn_readfirstlane(__hip_atomic_load(cnt + 64 * u.pm, __ATOMIC_RELAXED, __HIP_MEMORY_SCOPE_AGENT)) >= 64u) break;
                if (__builtin_amdgcn_s_memrealtime() - t0 > 20000000ull) break;
                __builtin_amdgcn_s_sleep(2);
            }
            __builtin_amdgcn_fence(__ATOMIC_ACQUIRE, "agent");
        }
        asm volatile("s_waitcnt vmcnt(0) lgkmcnt(0)" ::: "memory"); __builtin_amdgcn_s_barrier(); asm volatile("" ::: "memory");
        if (lane < 32) {
            const unsigned* sl = slots + (size_t)(u.pm * BM + row) * 8; float q = 0.f;
#pragma unroll
            for (int t = 0; t < 8; ++t) q += __uint_as_float(__hip_atomic_load(sl + t, __ATOMIC_RELAXED, __HIP_MEMORY_SCOPE_AGENT));
            S[row] = 1.0f / sqrtf(q * inv_n + eps);
        }
        asm volatile("s_waitcnt lgkmcnt(0)" ::: "memory"); __builtin_amdgcn_s_barrier(); asm volatile("" ::: "memory");
    }
};
struct EpiRmsRes {
    static constexpr bool PERM = false, AFTER_DRAIN = true;
    float* out; const float* g; int ldc; RowSsq st;
    __device__ __forceinline__ void fused(f32x4 (&acc)[2][2][4][2], const Unit& u, int wr, int wc, int fr, int fq, PG8_LAS unsigned char* lds, int wid, int lane) const {
        const PG8_LAS float* S = (const PG8_LAS float*)(lds + 8192);
        const int col0 = u.pn * BM + wc * 32 + 4 * fq;
        st.run(acc, u, wr, wc, fr, fq, lds, wid, lane);
#pragma unroll
        for (int ai = 0; ai < 2; ++ai)
#pragma unroll
            for (int m = 0; m < 4; ++m) { const int r = ai * HALF + wr * 64 + m * 16 + fr; const float sr = S[r]; const size_t off = (size_t)(u.pm * BM + r) * ldc + col0;
#pragma unroll
                for (int bj = 0; bj < 2; ++bj)
#pragma unroll
                    for (int n = 0; n < 2; ++n) { const f32x4 gv = *(const f32x4*)(g + col0 + bj * HALF + n * 16); const f32x4 bs = *(const f32x4*)(out + off + bj * HALF + n * 16);
                        *(f32x4*)(out + off + bj * HALF + n * 16) = bs + acc[ai][bj][m][n] * sr * gv; }
                if (m & 1) asm volatile("" ::: "memory"); }
    }
};
struct EpiRmsResRms {
    static constexpr bool PERM = false, AFTER_DRAIN = true;
    const float* xb; float* out; bf16_t* xn; const float* g1; const float* g2; int ldc; RowSsq st1, st2;
    __device__ __forceinline__ void fused(f32x4 (&acc)[2][2][4][2], const Unit& u, int wr, int wc, int fr, int fq, PG8_LAS unsigned char* lds, int wid, int lane) const {
        typedef unsigned u32x2v __attribute__((ext_vector_type(2)));
        const PG8_LAS float* S = (const PG8_LAS float*)(lds + 8192);
        const int col0 = u.pn * BM + wc * 32 + 4 * fq;
        st1.run(acc, u, wr, wc, fr, fq, lds, wid, lane);
#pragma unroll
        for (int ai = 0; ai < 2; ++ai)
#pragma unroll
            for (int m = 0; m < 4; ++m) { const int r = ai * HALF + wr * 64 + m * 16 + fr; const float sr = S[r]; const size_t off = (size_t)(u.pm * BM + r) * ldc + col0;
#pragma unroll
                for (int bj = 0; bj < 2; ++bj)
#pragma unroll
                    for (int n = 0; n < 2; ++n) { const f32x4 gv = *(const f32x4*)(g1 + col0 + bj * HALF + n * 16); const f32x4 bs = *(const f32x4*)(xb + off + bj * HALF + n * 16);
                        acc[ai][bj][m][n] = bs + acc[ai][bj][m][n] * sr * gv; }
                asm volatile("" : "+v"(acc[ai][0][m][0]), "+v"(acc[ai][0][m][1]), "+v"(acc[ai][1][m][0]), "+v"(acc[ai][1][m][1]));
                if (m & 1) asm volatile("" ::: "memory"); }
        st2.run(acc, u, wr, wc, fr, fq, lds, wid, lane);
#pragma unroll
        for (int ai = 0; ai < 2; ++ai)
#pragma unroll
            for (int m = 0; m < 4; ++m) { const int r = ai * HALF + wr * 64 + m * 16 + fr; const float sr = S[r]; const size_t off = (size_t)(u.pm * BM + r) * ldc + col0;
#pragma unroll
                for (int bj = 0; bj < 2; ++bj)
#pragma unroll
                    for (int n = 0; n < 2; ++n) { const f32x4 x1 = acc[ai][bj][m][n]; *(f32x4*)(out + off + bj * HALF + n * 16) = x1;
                        const f32x4 gv = *(const f32x4*)(g2 + col0 + bj * HALF + n * 16); const f32x4 o = x1 * sr * gv;
                        u32x2v w; w.x = cvt_pk_bf16(o[0], o[1]); w.y = cvt_pk_bf16(o[2], o[3]); *(u32x2v*)(xn + off + bj * HALF + n * 16) = w; }
                asm volatile("" ::: "memory"); }
    }
};

template <class Epi, class Sched, bool ALIGN_EPI = false, bool SP2 = false>
__device__ __forceinline__ void gemm_phase(PG8_LAS unsigned char* lds, const Gemm g, const Sched& S, const Epi& E) {
    const int tid = threadIdx.x, wid = __builtin_amdgcn_readfirstlane(tid >> 6), lane = tid & 63, wr = wid >> 2, wc = wid & 3, fr = lane & 15, fq = lane >> 4;
    const int K = g.K, nt = K / BK;
    unsigned voffA[2], voffB[2];
#pragma unroll
    for (int i = 0; i < 2; ++i) { int R, C; stage_rc(tid * 16 + i * 8192, R, C); const int Rb = Epi::PERM ? ((R & ~31) + perm32(R & 31)) : R;
        voffA[i] = (unsigned)(R * K + C) * 2u; voffB[i] = (unsigned)(Rb * K + C) * 2u; }
    const size_t kstep = (size_t)(BK * 2);
    const size_t hstep = (size_t)HALF * K * 2;
    const size_t tstep = 2 * hstep;
    const unsigned ldsw = (unsigned)wid * 1024u;
    const int aoff = lds_byte(wr * 64 + fr, fq * 8), boff = lds_byte(wc * 32 + fr, fq * 8);
#define PG8_SA(b, h) (((b) * 2 + (h)) * HTB)
#define PG8_SB(b, h) ((4 + (b) * 2 + (h)) * HTB)
#define PG8_STAGE(bufoff, gbase, voff) do { _Pragma("unroll") for (int _i = 0; _i < 2; ++_i) \
        __builtin_amdgcn_global_load_lds((const unsigned*)((const char*)(gbase) + (voff)[_i]), (PG8_LAS unsigned*)(lds + (bufoff) + ldsw + _i * 8192), 16, 0, 0); } while (0)
#define PG8_LDA(dst, b, h) do { _Pragma("unroll") for (int m = 0; m < 4; ++m) _Pragma("unroll") for (int k = 0; k < 2; ++k) dst[m][k] = *(const PG8_LAS bf16x8*)(lds + PG8_SA(b, h) + aoff + m * 2048 + k * 1024); } while (0)
#define PG8_LDB(dst, b, h) do { _Pragma("unroll") for (int n = 0; n < 2; ++n) _Pragma("unroll") for (int k = 0; k < 2; ++k) dst[n][k] = *(const PG8_LAS bf16x8*)(lds + PG8_SB(b, h) + boff + n * 2048 + k * 1024); } while (0)
#define PG8_MMA(ai, bj, At, Bt) do { __builtin_amdgcn_s_setprio(1); _Pragma("unroll") for (int m = 0; m < 4; ++m) _Pragma("unroll") for (int n = 0; n < 2; ++n) _Pragma("unroll") for (int k = 0; k < 2; ++k) \
        acc[ai][bj][m][n] = __builtin_amdgcn_mfma_f32_16x16x32_bf16(Bt[n][k], At[m][k], acc[ai][bj][m][n], 0, 0, 0); __builtin_amdgcn_s_setprio(0); } while (0)
#define PG8_WAIT_V(n) asm volatile("s_waitcnt vmcnt(" #n ")" ::: "memory")
#define PG8_WAIT_L(n) asm volatile("s_waitcnt lgkmcnt(" #n ")" ::: "memory")
#define PG8_BAR __builtin_amdgcn_s_barrier()
#define PG8_SCHED __builtin_amdgcn_sched_barrier(0)
    Unit cur, nxt; int ui = 0;
    if (!S.next(0, cur)) return;
    f32x4 acc[2][2][4][2];
#pragma unroll
    for (int a = 0; a < 2; ++a)
#pragma unroll
        for (int b = 0; b < 2; ++b)
#pragma unroll
            for (int m = 0; m < 4; ++m)
#pragma unroll
                for (int n = 0; n < 2; ++n) acc[a][b][m][n] = (f32x4){0.f, 0.f, 0.f, 0.f};
    bf16x8 At[4][2], B0[2][2], B1[2][2];
    const char* cA = (const char*)g.A + (size_t)cur.pm * tstep; const char* cB = (const char*)g.Bt + (size_t)cur.pn * tstep;
    S.a_ready(cur);
    if constexpr (SP2) {
        PG8_STAGE(PG8_SB(0, 0), cB, voffB); PG8_STAGE(PG8_SB(0, 1), cB + hstep, voffB); PG8_STAGE(PG8_SA(0, 0), cA, voffA); PG8_STAGE(PG8_SA(0, 1), cA + hstep, voffA);
        if (wr == 1) PG8_BAR;
        PG8_WAIT_V(2); PG8_BAR;
        PG8_STAGE(PG8_SB(1, 0), cB + kstep, voffB); PG8_STAGE(PG8_SA(1, 0), cA + kstep, voffA); PG8_STAGE(PG8_SB(1, 1), cB + hstep + kstep, voffB);
        PG8_WAIT_V(6); PG8_BAR;
    } else {
        PG8_STAGE(PG8_SB(0, 0), cB, voffB); PG8_STAGE(PG8_SA(0, 0), cA, voffA); PG8_STAGE(PG8_SB(0, 1), cB + hstep, voffB); PG8_STAGE(PG8_SA(0, 1), cA + hstep, voffA);
        if (wr == 1) PG8_BAR;
        PG8_WAIT_V(4); PG8_BAR;
        PG8_STAGE(PG8_SB(1, 0), cB + kstep, voffB); PG8_STAGE(PG8_SA(1, 0), cA + kstep, voffA); PG8_STAGE(PG8_SB(1, 1), cB + hstep + kstep, voffB);
        PG8_WAIT_V(6); PG8_BAR;
    }
    for (;;) {
        const bool has_next = S.next(ui + 1, nxt);
        const char* nA = has_next ? (const char*)g.A + (size_t)nxt.pm * tstep : cA; const char* nB = has_next ? (const char*)g.Bt + (size_t)nxt.pn * tstep : cB;
        for (int t = 0; t < nt; t += 2) {
            const bool last = (t == nt - 2);
            const char* a1 = cA + (size_t)(t + 1) * kstep;
            const char* a2 = last ? nA : cA + (size_t)(t + 2) * kstep; const char* b2 = last ? nB : cB + (size_t)(t + 2) * kstep;
            const char* a3 = a2 + kstep; const char* b3 = b2 + kstep;
            if (last && has_next) S.a_ready(nxt);
            if constexpr (SP2) {
            PG8_LDB(B0, 0, 0); PG8_LDB(B1, 0, 1); PG8_SCHED; PG8_LDA(At, 0, 0); PG8_STAGE(PG8_SA(1, 1), a1 + hstep, voffA);
            PG8_WAIT_V(8); PG8_WAIT_L(0); PG8_BAR; PG8_MMA(0, 0, At, B0); PG8_MMA(0, 1, At, B1); PG8_BAR; PG8_SCHED;
            PG8_LDA(At, 0, 1); PG8_STAGE(PG8_SB(0, 0), b2, voffB); PG8_STAGE(PG8_SB(0, 1), b2 + hstep, voffB); PG8_STAGE(PG8_SA(0, 0), a2, voffA);
            PG8_WAIT_V(8); PG8_WAIT_L(0); PG8_BAR; PG8_MMA(1, 0, At, B0); PG8_MMA(1, 1, At, B1); PG8_BAR; PG8_SCHED;
            PG8_LDB(B0, 1, 0); PG8_LDB(B1, 1, 1); PG8_SCHED; PG8_LDA(At, 1, 0); PG8_STAGE(PG8_SA(0, 1), a2 + hstep, voffA);
            PG8_WAIT_V(8); PG8_WAIT_L(0); PG8_BAR; PG8_MMA(0, 0, At, B0); PG8_MMA(0, 1, At, B1); PG8_BAR; PG8_SCHED;
            PG8_LDA(At, 1, 1); PG8_STAGE(PG8_SB(1, 0), b3, voffB); PG8_STAGE(PG8_SB(1, 1), b3 + hstep, voffB); PG8_STAGE(PG8_SA(1, 0), a3, voffA);
            PG8_WAIT_V(8); PG8_WAIT_L(0); PG8_BAR; PG8_MMA(1, 0, At, B0); PG8_MMA(1, 1, At, B1); PG8_BAR; PG8_SCHED;
            } else {
            PG8_LDB(B0, 0, 0); PG8_SCHED; PG8_LDA(At, 0, 0); PG8_STAGE(PG8_SA(1, 1), a1 + hstep, voffA);
            PG8_WAIT_L(8); PG8_BAR; PG8_WAIT_L(0); PG8_MMA(0, 0, At, B0); PG8_BAR; PG8_SCHED;
            PG8_LDB(B1, 0, 1); PG8_STAGE(PG8_SB(0, 0), b2, voffB);
            PG8_BAR; PG8_WAIT_L(0); PG8_MMA(0, 1, At, B1); PG8_BAR;
            PG8_LDA(At, 0, 1); PG8_STAGE(PG8_SA(0, 0), a2, voffA);
            PG8_BAR; PG8_WAIT_L(0); PG8_MMA(1, 0, At, B0); PG8_BAR; PG8_SCHED;
            PG8_STAGE(PG8_SB(0, 1), b2 + hstep, voffB);
            PG8_WAIT_V(6); PG8_BAR; PG8_MMA(1, 1, At, B1); PG8_BAR;
            PG8_LDB(B0, 1, 0); PG8_SCHED; PG8_LDA(At, 1, 0); PG8_STAGE(PG8_SA(0, 1), a2 + hstep, voffA);
            PG8_WAIT_L(8); PG8_BAR; PG8_WAIT_L(0); PG8_MMA(0, 0, At, B0); PG8_BAR; PG8_SCHED;
            PG8_LDB(B1, 1, 1); PG8_STAGE(PG8_SB(1, 0), b3, voffB);
            PG8_BAR; PG8_WAIT_L(0); PG8_MMA(0, 1, At, B1); PG8_BAR;
            PG8_LDA(At, 1, 1); PG8_STAGE(PG8_SA(1, 0), a3, voffA);
            PG8_BAR; PG8_WAIT_L(0); PG8_MMA(1, 0, At, B0); PG8_BAR; PG8_SCHED;
            PG8_STAGE(PG8_SB(1, 1), b3 + hstep, voffB);
            PG8_WAIT_V(6); PG8_BAR; PG8_MMA(1, 1, At, B1); PG8_BAR;
            }
        }
        if constexpr (ALIGN_EPI) { if (wr == 0) PG8_BAR; }
        if constexpr (!Epi::AFTER_DRAIN) { E(acc, cur, wr, wc, fr, fq); S.done(cur); }
        if (!has_next) break;
#pragma unroll
        for (int a = 0; a < 2; ++a)
#pragma unroll
            for (int b = 0; b < 2; ++b)
#pragma unroll
                for (int m = 0; m < 4; ++m)
#pragma unroll
                    for (int n = 0; n < 2; ++n) acc[a][b][m][n] = (f32x4){0.f, 0.f, 0.f, 0.f};
        cur = nxt; cA = nA; cB = nB; ++ui;
        if constexpr (ALIGN_EPI) { if (wr == 1) PG8_BAR; }
    }
    PG8_WAIT_V(0);
    if constexpr (!ALIGN_EPI) { if (wr == 0) PG8_BAR; }
    PG8_BAR;
    if constexpr (Epi::AFTER_DRAIN) { E.fused(acc, cur, wr, wc, fr, fq, lds, wid, lane); S.done(cur); }
#undef PG8_SA
#undef PG8_SB
#undef PG8_STAGE
#undef PG8_LDA
#undef PG8_LDB
#undef PG8_MMA
#undef PG8_WAIT_V
#undef PG8_WAIT_L
#undef PG8_BAR
#undef PG8_SCHED
}
}
namespace att {
using bf16 = unsigned short;
constexpr int   D = 128, NW = 8, QBLK = 32, KVBLK = 64;
constexpr float SCALE = 0.088388347648318440f;
constexpr float THR = 8.f;
constexpr float MINIT = -30000.f;
constexpr size_t SHM_V = KVBLK * D * 2, SHM_K = KVBLK * D * 2;
constexpr size_t SHM_ATTN = 2 * SHM_V + 2 * SHM_K + NW * 64 * 4 + 1024;
using bf16x8 = __attribute__((ext_vector_type(8))) short;
using s16x4  = __attribute__((ext_vector_type(4))) short;
using f32x16 = __attribute__((ext_vector_type(16))) float;
using u32x4  = __attribute__((ext_vector_type(4))) unsigned;
#define KSWZ(row, colB) ((row) * 256 + ((colB) ^ (((row) & 7) << 4)))
#define SBAR() __builtin_amdgcn_sched_barrier(0)
__device__ __forceinline__ int crow(int r, int hi) { return (r & 3) + 8 * (r >> 2) + 4 * hi; }
__device__ __forceinline__ unsigned cvtpk(float lo, float hi) {
  unsigned r; asm volatile("v_cvt_pk_bf16_f32 %0, %1, %2" : "=v"(r) : "v"(lo), "v"(hi)); return r;
}
__device__ __forceinline__ void partialSM(f32x16& p0, f32x16& p1, float& m_reg, float& mn, float& alpha) {
  constexpr float C = SCALE * 1.4426950408889634f;
  float pmax = p0[0]; for (int r = 1; r < 16; ++r) pmax = fmaxf(pmax, p0[r]); for (int r = 0; r < 16; ++r) pmax = fmaxf(pmax, p1[r]);
  { auto rr = __builtin_amdgcn_permlane32_swap(__float_as_uint(pmax), __float_as_uint(pmax), false, false);
    pmax = fmaxf(__uint_as_float(rr[0]), __uint_as_float(rr[1])); }
  if (__builtin_expect(__all(pmax - m_reg <= THR / SCALE), 1)) { mn = m_reg; alpha = 1.f; }
  else { mn = fmaxf(m_reg, pmax); alpha = __builtin_amdgcn_exp2f((m_reg - mn) * C); m_reg = mn; }
  float mnC = -mn * C;
  for (int r = 0; r < 16; ++r) p0[r] = fmaf(p0[r], C, mnC); for (int r = 0; r < 16; ++r) p1[r] = fmaf(p1[r], C, mnC);
  for (int r = 0; r < 16; ++r) p0[r] = __builtin_amdgcn_exp2f(p0[r]);
}
__device__ __forceinline__ void finishSM(f32x16& p0, f32x16& p1, float alpha, float& l_reg, bf16x8& pa0, bf16x8& pa1, bf16x8& pa2, bf16x8& pa3) {
  for (int r = 0; r < 16; ++r) p1[r] = __builtin_amdgcn_exp2f(p1[r]);
  float ps = 0; for (int r = 0; r < 16; ++r) ps += p0[r]; for (int r = 0; r < 16; ++r) ps += p1[r];
  { auto rr = __builtin_amdgcn_permlane32_swap(__float_as_uint(ps), __float_as_uint(ps), false, false);
    ps = __uint_as_float(rr[0]) + __uint_as_float(rr[1]); }
  l_reg = l_reg * alpha + ps;
#define PK4(P, BASE, OUT) do { unsigned a0 = cvtpk(P[BASE + 0], P[BASE + 1]), a1 = cvtpk(P[BASE + 2], P[BASE + 3]);   \
    unsigned b0 = cvtpk(P[BASE + 4], P[BASE + 5]), b1 = cvtpk(P[BASE + 6], P[BASE + 7]);                              \
    auto r0 = __builtin_amdgcn_permlane32_swap(a0, b0, false, false); auto r1 = __builtin_amdgcn_permlane32_swap(a1, b1, false, false); \
    u32x4 w = {r0[0], r1[0], r0[1], r1[1]}; OUT = *reinterpret_cast<bf16x8*>(&w); } while (0)
  PK4(p0, 0, pa0); PK4(p0, 8, pa1); PK4(p1, 0, pa2); PK4(p1, 8, pa3);
#undef PK4
}
__device__ __forceinline__ void qkt(f32x16& p0, f32x16& p1, const bf16* Ks, const bf16x8* qr, int r32, int hi) {
  p0 = f32x16{}; p1 = f32x16{};
  for (int d0 = 0; d0 < 8; ++d0) { int cb = (d0 * 16 + hi * 8) * 2;
    bf16x8 b0 = *reinterpret_cast<const bf16x8*>((const char*)Ks + KSWZ(r32, cb));
    bf16x8 b1 = *reinterpret_cast<const bf16x8*>((const char*)Ks + KSWZ(32 + r32, cb));
    p0 = __builtin_amdgcn_mfma_f32_32x32x16_bf16(b0, qr[d0], p0, 0, 0, 0);
    p1 = __builtin_amdgcn_mfma_f32_32x32x16_bf16(b1, qr[d0], p1, 0, 0, 0); }
}
__device__ __forceinline__ int v_st(int k, int c) { const int kk = (k & ~0xC) | ((k & 4) << 1) | ((k & 8) >> 1); return ((kk >> 3) * 4 + (c >> 5)) * 512 + ((kk & 7) * 32 + (c & 31)) * 2; }
__device__ __forceinline__ int v_rd_base(int lane) { return ((lane & 3) << 3) | (((lane >> 2) & 3) << 6) | (((lane >> 4) & 1) << 5) | (((lane >> 5) & 1) << 8); }
constexpr int v_rd_off(int d0, int ks, int half) { return d0 * 512 + ks * 4096 + half * 2048; }
template <int OFF> __device__ __forceinline__ s16x4 tr_read(int vb) {
  s16x4 r; asm volatile("ds_read_b64_tr_b16 %0, %1 offset:%2" : "=&v"(r) : "v"(vb), "i"(OFF) : "memory"); return r;
}
template <int D0> __device__ __forceinline__ void pv_one(f32x16& od, int vb, bf16x8 pa0, bf16x8 pa1, bf16x8 pa2, bf16x8 pa3) {
  const s16x4 l0 = tr_read<v_rd_off(D0, 0, 0)>(vb), h0 = tr_read<v_rd_off(D0, 0, 1)>(vb), l1 = tr_read<v_rd_off(D0, 1, 0)>(vb), h1 = tr_read<v_rd_off(D0, 1, 1)>(vb);
  const s16x4 l2 = tr_read<v_rd_off(D0, 2, 0)>(vb), h2 = tr_read<v_rd_off(D0, 2, 1)>(vb), l3 = tr_read<v_rd_off(D0, 3, 0)>(vb), h3 = tr_read<v_rd_off(D0, 3, 1)>(vb);
  asm volatile("s_waitcnt lgkmcnt(0)" ::: "memory"); SBAR();
#define PK(L, H) (bf16x8){L[0], L[1], L[2], L[3], H[0], H[1], H[2], H[3]}
  od = __builtin_amdgcn_mfma_f32_32x32x16_bf16(pa0, PK(l0, h0), od, 0, 0, 0);
  od = __builtin_amdgcn_mfma_f32_32x32x16_bf16(pa1, PK(l1, h1), od, 0, 0, 0);
  od = __builtin_amdgcn_mfma_f32_32x32x16_bf16(pa2, PK(l2, h2), od, 0, 0, 0);
  od = __builtin_amdgcn_mfma_f32_32x32x16_bf16(pa3, PK(l3, h3), od, 0, 0, 0);
#undef PK
}
__device__ __forceinline__ void pv_d0(f32x16* o, int vb, bf16x8 pa0, bf16x8 pa1, bf16x8 pa2, bf16x8 pa3) {
  pv_one<0>(o[0], vb, pa0, pa1, pa2, pa3); pv_one<1>(o[1], vb, pa0, pa1, pa2, pa3); pv_one<2>(o[2], vb, pa0, pa1, pa2, pa3); pv_one<3>(o[3], vb, pa0, pa1, pa2, pa3);
}
__device__ __forceinline__ void band_mask(f32x16& p0, f32x16& p1, int base, int hi, const float* biasL) {
#pragma unroll
  for (int r = 0; r < 16; ++r) {
    const int k0 = base + crow(r, hi), k1 = k0 + 32;
    const int c0 = min(max(k0, 0), 128), c1 = min(max(k1, 0), 128);
    const float b0 = biasL[c0], b1 = biasL[c1];
    p0[r] = ((unsigned)k0 <= 128u) ? p0[r] + b0 : MINIT;
    p1[r] = ((unsigned)k1 <= 128u) ? p1[r] + b1 : MINIT;
  }
}
__device__ __forceinline__ unsigned short f2bf(float f) { unsigned u = __builtin_bit_cast(unsigned, f); return (unsigned short)((u + 0x7fffu + ((u >> 16) & 1u)) >> 16); }

typedef float f32x2r __attribute__((ext_vector_type(2)));
typedef float f32x4r __attribute__((ext_vector_type(4)));
template <int MODE, bool QROPE = false>
__device__ __forceinline__ void attn_unit(const bf16* __restrict__ Qh, const bf16* __restrict__ Kh, const bf16* __restrict__ Vh, bf16* __restrict__ Oh,
                                          float* __restrict__ lse_o, const int ldk, const int NT, const int dil, const int two, const int m0, const int ms,
                                          const float* __restrict__ bias_g, char* lds, const float* __restrict__ qgain = nullptr, const f32x2r* __restrict__ rope = nullptr, const int s0 = 0) {
  constexpr int LDQ = 4096, LDO = 2048;
  const int tid = threadIdx.x, wid = tid >> 6, lane = tid & 63, r32 = lane & 31, hi = lane >> 5;
  bf16* V_lds = (bf16*)lds; bf16* K_lds = (bf16*)(lds + 2 * SHM_V);
  float* ws = (float*)(lds + 2 * SHM_V + 2 * SHM_K) + wid * 64; float* li_l = ws; float* al_l = ws + 32;
  float* biasL = (float*)(lds + 2 * SHM_V + 2 * SHM_K + NW * 64 * 4);
  float m_reg = MINIT, l_reg = 0; f32x16 o[4] = {}; bf16x8 qr[8];
  const int qi = wid * QBLK + r32;
  int qt = qi, qpos = 0;
  if (MODE == 1) { qt = two ? ((qi & 127) * dil + (qi >> 7)) : qi * dil; qpos = two ? ((qi & 127) + 4096 * (qi >> 7)) : (m0 + qi); }
  const bf16* Qw = Qh + (long)qt * LDQ + hi * 8;
#pragma unroll
  for (int d0 = 0; d0 < 8; ++d0) qr[d0] = *reinterpret_cast<const bf16x8*>(Qw + d0 * 16);
  if (QROPE) {
    float f[8][8]; float ss = 0.f;
#pragma unroll
    for (int d0 = 0; d0 < 8; ++d0)
#pragma unroll
      for (int e = 0; e < 8; ++e) { f[d0][e] = __uint_as_float(((unsigned)(unsigned short)qr[d0][e]) << 16); ss += f[d0][e] * f[d0][e]; }
    { auto rr = __builtin_amdgcn_permlane32_swap(__float_as_uint(ss), __float_as_uint(ss), false, false); ss = __uint_as_float(rr[0]) + __uint_as_float(rr[1]); }
    const float rstd = 1.0f / sqrtf(ss * (1.0f / 128.0f) + 1e-6f);
#pragma unroll
    for (int d0 = 0; d0 < 8; ++d0) { const f32x4r g0 = *reinterpret_cast<const f32x4r*>(qgain + d0 * 16 + hi * 8), g1 = *reinterpret_cast<const f32x4r*>(qgain + d0 * 16 + hi * 8 + 4);
#pragma unroll
      for (int e = 0; e < 4; ++e) { f[d0][e] *= rstd * g0[e]; f[d0][4 + e] *= rstd * g1[e]; } }
    const int sq = s0 + qi;
#pragma unroll
    for (int hf = 0; hf < 2; ++hf) { const int pos = hf ? (sq & 63) : (sq >> 6);
#pragma unroll
      for (int dd = 0; dd < 2; ++dd) { const f32x2r* rp = rope + pos * 32 + 16 * dd + 8 * hi;
#pragma unroll
        for (int e = 0; e < 8; ++e) { const f32x2r cs = rp[e]; const float a1 = f[4 * hf + dd][e], a2 = f[4 * hf + dd + 2][e];
          f[4 * hf + dd][e] = a1 * cs.x - a2 * cs.y; f[4 * hf + dd + 2][e] = a2 * cs.x + a1 * cs.y; } } }
#pragma unroll
    for (int d0 = 0; d0 < 8; ++d0) { u32x4 w = {cvtpk(f[d0][0], f[d0][1]), cvtpk(f[d0][2], f[d0][3]), cvtpk(f[d0][4], f[d0][5]), cvtpk(f[d0][6], f[d0][7])}; qr[d0] = *reinterpret_cast<bf16x8*>(&w); }
  }
  if (MODE == 1) {
    if (tid < 129) {
      const int rel = (tid - 64) * dil, n = rel < 0 ? -rel : rel; const float nf = (float)(n > 1 ? n : 1);
      int large = 8 + (int)(logf(nf * 0.125f) / 4.852030263919617f * 8.0f); large = large < 15 ? large : 15;
      const int bucket = (rel > 0 ? 16 : 0) + (n < 8 ? n : large);
      biasL[tid] = bias_g[bucket * 6] * (1.0f / SCALE);
    }
  }
  const int rs = (MODE == 1) ? dil : 1;
  const int sr = tid >> 4, sc = (tid & 15) * 8, vst0 = v_st(sr, sc), vst1 = v_st(32 + sr, sc);
  const int vb0 = (int)(uintptr_t)V_lds + v_rd_base(lane);
  const unsigned lo0 = (unsigned)(sr * rs * ldk + sc), lo1 = lo0 + (unsigned)(32 * rs * ldk);
  constexpr int SDEPTH = (MODE == 1) ? 1 : 2;
  struct { bf16x8 vs0, vs1, ks0, ks1; } sr_[SDEPTH];
#define KTOK0(j) ((MODE == 0) ? 64 * (j) : (two ? ((64 * ((j) & 1)) * dil + ((j) >> 1)) : (ms + 64 * (j)) * dil))
#define KPOS0(j) (two ? (64 * ((j) & 1) + 4096 * ((j) >> 1)) : (ms + 64 * (j)))
#define SLOAD(i, j) do { const long tb_ = (long)__builtin_amdgcn_readfirstlane(KTOK0(j)) * ldk; const bf16* kt_ = Kh + tb_; const bf16* vt_ = Vh + tb_; \
    sr_[i].vs0 = *reinterpret_cast<const bf16x8*>(vt_ + lo0); sr_[i].vs1 = *reinterpret_cast<const bf16x8*>(vt_ + lo1); \
    sr_[i].ks0 = *reinterpret_cast<const bf16x8*>(kt_ + lo0); sr_[i].ks1 = *reinterpret_cast<const bf16x8*>(kt_ + lo1); } while (0)
#define SWRITE(b, i) do { *(bf16x8*)((char*)V_lds + (b) * SHM_V + vst0) = sr_[i].vs0;          \
    *(bf16x8*)((char*)V_lds + (b) * SHM_V + vst1) = sr_[i].vs1; int kc = sc * 2;               \
    *(bf16x8*)((char*)K_lds + (b) * SHM_K + KSWZ(sr, kc)) = sr_[i].ks0;                       \
    *(bf16x8*)((char*)K_lds + (b) * SHM_K + KSWZ(32 + sr, kc)) = sr_[i].ks1; } while (0)
#define SWAIT() do { if constexpr (SDEPTH == 2) asm volatile("s_waitcnt vmcnt(4)" ::: "memory"); else asm volatile("s_waitcnt vmcnt(0)" ::: "memory"); } while (0)
#define RESC(a) do { if (__any((a) < 1.f)) { if (hi == 0) al_l[r32] = (a); asm volatile("s_waitcnt lgkmcnt(0)" ::: "memory"); \
    for (int d = 0; d < 4; ++d) for (int r = 0; r < 16; ++r) o[d][r] *= al_l[crow(r, hi)]; } } while (0)
#define MASK(P0, P1, j) do { if (MODE == 1) band_mask(P0, P1, KPOS0(j) - qpos + 64, hi, biasL); } while (0)
  f32x16 pA0, pA1, pB0, pB1; float mnA, mnB, alA, alB; bf16x8 pa0, pa1, pa2, pa3;
  constexpr int SE = 0, SO = SDEPTH - 1;
  SLOAD(SE, 0); asm volatile("s_waitcnt vmcnt(0)" ::: "memory"); SWRITE(0, SE); __syncthreads();
  qkt(pA0, pA1, K_lds, qr, r32, hi); MASK(pA0, pA1, 0); partialSM(pA0, pA1, m_reg, mnA, alA);
  SLOAD(SO, 1); if constexpr (SDEPTH == 2) { if (2 < NT) SLOAD(SE, 2); }
  SWAIT(); SWRITE(1, SO); __syncthreads();
  for (int j = 1; j + 1 < NT; j += 2) {
    SBAR(); qkt(pB0, pB1, (bf16*)((char*)K_lds + SHM_K), qr, r32, hi);
    finishSM(pA0, pA1, alA, l_reg, pa0, pa1, pa2, pa3); SBAR();
    SLOAD(SO, j + SDEPTH); SBAR();
    pv_d0(o, vb0, pa0, pa1, pa2, pa3); MASK(pB0, pB1, j); partialSM(pB0, pB1, m_reg, mnB, alB);
    __syncthreads(); SWAIT(); SWRITE(0, SE);
    RESC(alB); __syncthreads();
    SBAR(); qkt(pA0, pA1, K_lds, qr, r32, hi);
    finishSM(pB0, pB1, alB, l_reg, pa0, pa1, pa2, pa3); SBAR();
    if (SDEPTH == 1 || j + 3 < NT) SLOAD(SE, j + 1 + SDEPTH); SBAR();
    pv_d0(o, vb0 + (int)SHM_V, pa0, pa1, pa2, pa3); MASK(pA0, pA1, j + 1); partialSM(pA0, pA1, m_reg, mnA, alA);
    __syncthreads(); SWAIT(); SWRITE(1, SO);
    RESC(alA); __syncthreads();
  }
  SBAR(); qkt(pB0, pB1, (bf16*)((char*)K_lds + SHM_K), qr, r32, hi);
  finishSM(pA0, pA1, alA, l_reg, pa0, pa1, pa2, pa3); SBAR();
  pv_d0(o, vb0, pa0, pa1, pa2, pa3); MASK(pB0, pB1, NT - 1); partialSM(pB0, pB1, m_reg, mnB, alB);
  __syncthreads(); RESC(alB);
  finishSM(pB0, pB1, alB, l_reg, pa0, pa1, pa2, pa3); SBAR();
  pv_d0(o, vb0 + (int)SHM_V, pa0, pa1, pa2, pa3);
  if (hi == 0) li_l[r32] = l_reg; asm volatile("s_waitcnt lgkmcnt(0)" ::: "memory");
  float rli[16];
#pragma unroll
  for (int r = 0; r < 16; ++r) rli[r] = __builtin_amdgcn_rcpf(li_l[crow(r, hi)]);
#pragma unroll
  for (int r = 0; r < 16; ++r) { const int qo = wid * QBLK + crow(r, hi);
    long ot = qo; if (MODE == 1) ot = two ? ((qo & 127) * dil + (qo >> 7)) : qo * dil;
    bf16* Ow = Oh + ot * LDO + r32;
#pragma unroll
    for (int d0 = 0; d0 < 4; ++d0) Ow[d0 * 32] = f2bf(o[d0][r] * rli[r]); }
  if (MODE == 1) { if (hi == 0) lse_o[(long)qt * 6] = m_reg * SCALE + logf(l_reg); }
#undef KTOK0
#undef KPOS0
#undef SLOAD
#undef SWRITE
#undef SWAIT
#undef RESC
#undef MASK
}

__device__ __forceinline__ void attn_unit_band(const bf16* __restrict__ Qh, const bf16* __restrict__ Kh, const bf16* __restrict__ Vh, bf16* __restrict__ Oh,
                                               float* __restrict__ lse_o, const int ldk, const int NT, const int dil, const int two, const int m0, const int ms,
                                               const float* __restrict__ bias_g, char* lds) {
  constexpr int LDQ = 4096, LDO = 2048;
  const int tid = threadIdx.x, wid = tid >> 6, lane = tid & 63, r32 = lane & 31, hi = lane >> 5;
  bf16* V_lds = (bf16*)lds; bf16* K_lds = (bf16*)(lds + 2 * SHM_V);
  float* ws = (float*)(lds + 2 * SHM_V + 2 * SHM_K) + wid * 64; float* li_l = ws; float* al_l = ws + 32;
  float* biasL = (float*)(lds + 2 * SHM_V + 2 * SHM_K + NW * 64 * 4);
  float m_reg = MINIT, l_reg = 0; f32x16 o[4] = {}; bf16x8 qr[8];
  const int qi = wid * QBLK + r32;
  const int qt = two ? ((qi & 127) * dil + (qi >> 7)) : qi * dil, qpos = two ? ((qi & 127) + 4096 * (qi >> 7)) : (m0 + qi);
  const bf16* Qw = Qh + (long)qt * LDQ + hi * 8;
#pragma unroll
  for (int d0 = 0; d0 < 8; ++d0) qr[d0] = *reinterpret_cast<const bf16x8*>(Qw + d0 * 16);
  if (tid < 129) {
    const int rel = (tid - 64) * dil, n = rel < 0 ? -rel : rel; const float nf = (float)(n > 1 ? n : 1);
    int large = 8 + (int)(logf(nf * 0.125f) / 4.852030263919617f * 8.0f); large = large < 15 ? large : 15;
    const int bucket = (rel > 0 ? 16 : 0) + (n < 8 ? n : large);
    biasL[tid] = bias_g[bucket * 6] * (1.0f / SCALE);
  }
  const int sr = tid >> 4, sc = (tid & 15) * 8, vst0 = v_st(sr, sc), vst1 = v_st(32 + sr, sc);
  const int vb0 = (int)(uintptr_t)V_lds + v_rd_base(lane);
  const unsigned lo0 = (unsigned)(sr * dil * ldk + sc), lo1 = lo0 + (unsigned)(32 * dil * ldk);
  bf16x8 vs0, vs1, ks0, ks1;
#define KTOK0(j) (two ? ((64 * ((j) & 1)) * dil + ((j) >> 1)) : (ms + 64 * (j)) * dil)
#define KPOS0(j) (two ? (64 * ((j) & 1) + 4096 * ((j) >> 1)) : (ms + 64 * (j)))
#define SLOAD(j) do { const long tb_ = (long)__builtin_amdgcn_readfirstlane(KTOK0(j)) * ldk; const bf16* kt_ = Kh + tb_; const bf16* vt_ = Vh + tb_; \
    vs0 = *reinterpret_cast<const bf16x8*>(vt_ + lo0); vs1 = *reinterpret_cast<const bf16x8*>(vt_ + lo1); \
    ks0 = *reinterpret_cast<const bf16x8*>(kt_ + lo0); ks1 = *reinterpret_cast<const bf16x8*>(kt_ + lo1); } while (0)
  const int qw0_ = wid * QBLK, qlo_w = __builtin_amdgcn_readfirstlane(two ? ((qw0_ & 127) + 4096 * (qw0_ >> 7)) : (m0 + qw0_)), qhi_w = qlo_w + 31;
  SLOAD(0);
  for (int j = 0; j < NT; ++j) {
    asm volatile("s_waitcnt vmcnt(0)" ::: "memory");
    __syncthreads();
    *(bf16x8*)((char*)V_lds + vst0) = vs0; *(bf16x8*)((char*)V_lds + vst1) = vs1;
    *(bf16x8*)((char*)K_lds + KSWZ(sr, sc * 2)) = ks0; *(bf16x8*)((char*)K_lds + KSWZ(32 + sr, sc * 2)) = ks1;
    __syncthreads();
    if (j + 1 < NT) SLOAD(j + 1);
    const int kp0_ = KPOS0(j);
    if (kp0_ > qhi_w + 64 || kp0_ + 63 < qlo_w - 64) continue;
    f32x16 p0, p1; float mn, al; bf16x8 pa0, pa1, pa2, pa3;
    SBAR(); qkt(p0, p1, K_lds, qr, r32, hi);
    band_mask(p0, p1, KPOS0(j) - qpos + 64, hi, biasL);
    partialSM(p0, p1, m_reg, mn, al);
    if (__any(al < 1.f)) { if (hi == 0) al_l[r32] = al; asm volatile("s_waitcnt lgkmcnt(0)" ::: "memory");
#pragma unroll
      for (int d = 0; d < 4; ++d)
#pragma unroll
        for (int r = 0; r < 16; ++r) o[d][r] *= al_l[crow(r, hi)]; }
    finishSM(p0, p1, al, l_reg, pa0, pa1, pa2, pa3); SBAR();
    pv_d0(o, vb0, pa0, pa1, pa2, pa3);
  }
  if (hi == 0) li_l[r32] = l_reg; asm volatile("s_waitcnt lgkmcnt(0)" ::: "memory");
  float rli[16];
#pragma unroll
  for (int r = 0; r < 16; ++r) rli[r] = __builtin_amdgcn_rcpf(li_l[crow(r, hi)]);
#pragma unroll
  for (int r = 0; r < 16; ++r) { const int qo = wid * QBLK + crow(r, hi);
    const long ot = two ? ((qo & 127) * dil + (qo >> 7)) : qo * dil;
    bf16* Ow = Oh + ot * LDO + r32;
#pragma unroll
    for (int d0 = 0; d0 < 4; ++d0) Ow[d0 * 32] = f2bf(o[d0][r] * rli[r]); }
  if (hi == 0) lse_o[(long)qt * 6] = m_reg * SCALE + logf(l_reg);
#undef KTOK0
#undef KPOS0
#undef SLOAD
}
#undef KSWZ
#undef SBAR
}
#define LAS __attribute__((address_space(3)))
#define XB_TMO      128
#define XB_XCNT(j)  (256  + 64 * (j))
#define XB_XSUB(j)  (1280 + 64 * (j))
#define XB_XGEN(j)  (2304 + 64 * (j))
#define XB_TOP      3328
#define XB_TOPGEN   3392
#define XCD_BAR_WORDS 3456
#define XB_SPIN_CAP (1u << 18)

__device__ __forceinline__ unsigned xb_ld(unsigned* p)              { return __hip_atomic_load(p, __ATOMIC_RELAXED, __HIP_MEMORY_SCOPE_AGENT); }
__device__ __forceinline__ unsigned xb_add(unsigned* p, unsigned v) { return __hip_atomic_fetch_add(p, v, __ATOMIC_RELAXED, __HIP_MEMORY_SCOPE_AGENT); }
__device__ __forceinline__ unsigned xb_xcc_id() { return (unsigned)__builtin_amdgcn_s_getreg((3 << 11) | 20) & 0xFu; }
#define XB_SPIN(cond, bar) do { unsigned _sp = 0; while (cond) { __builtin_amdgcn_s_sleep(1); \
    if ((++_sp & 255u) == 0u) { if (xb_ld(&(bar)[XB_TMO])) break; if (_sp > XB_SPIN_CAP) { atomicAdd(&(bar)[XB_TMO], 1u); break; } } } } while (0)

struct XcdBarrier {
    unsigned* bar; unsigned x;
    volatile LAS unsigned* st;
};

__device__ __forceinline__ XcdBarrier xcd_barrier_post(unsigned* bar, volatile LAS unsigned* st) {
    XcdBarrier b; b.bar = bar; b.x = xb_xcc_id(); b.st = st;
    if (threadIdx.x == 0) (void)xb_add(&bar[XB_XCNT(b.x)], 1u);
    return b;
}
__device__ __forceinline__ void xcd_barrier_complete(unsigned* bar, unsigned x, unsigned& nloc, unsigned& nx) {
    const unsigned G = gridDim.x * gridDim.y * gridDim.z;
    unsigned sum, cnt, mine, sp = 0u;
    for (;;) {
        sum = 0u; cnt = 0u; mine = 0u;
#pragma unroll
        for (unsigned j = 0; j < 16; ++j) { const unsigned c = xb_ld(&bar[XB_XCNT(j)]); sum += c; cnt += (c > 0u) ? 1u : 0u; mine = (j == x) ? c : mine; }
        if (sum == G) break;
        __builtin_amdgcn_s_sleep(1);
        if ((++sp & 255u) == 0u) { if (xb_ld(&bar[XB_TMO])) break; if (sp > XB_SPIN_CAP) { atomicAdd(&bar[XB_TMO], 1u); break; } }
    }
    nloc = mine > 0u ? mine : 1u; nx = cnt > 0u ? cnt : 1u;
}

__device__ __forceinline__ void xcd_barrier(const XcdBarrier& b) {
    asm volatile("s_waitcnt vmcnt(0)" ::: "memory");
    __syncthreads();
    if (threadIdx.x == 0) {
        unsigned* bar = b.bar;
        __builtin_amdgcn_s_waitcnt(0);
        unsigned nloc = b.st[0], nx = b.st[1];
        if (nloc == 0u) { xcd_barrier_complete(bar, b.x, nloc, nx); b.st[0] = nloc; b.st[1] = nx; }
        const unsigned old = xb_add(&bar[XB_XSUB(b.x)], 1u);
        const unsigned gen = old / nloc;
        if (old + 1u == (gen + 1u) * nloc) {
            __builtin_amdgcn_fence(__ATOMIC_RELEASE, "agent");
            asm volatile("s_waitcnt vmcnt(0)" ::: "memory");
            const unsigned og = xb_add(&bar[XB_TOP], 1u);
            const unsigned tg = og / nx;
            if (og + 1u == (tg + 1u) * nx) xb_add(&bar[XB_TOPGEN], 1u);
            else XB_SPIN(xb_ld(&bar[XB_TOPGEN]) == tg, bar);
            __builtin_amdgcn_fence(__ATOMIC_ACQUIRE, "agent");
            xb_add(&bar[XB_XGEN(b.x)], 1u);
            asm volatile("s_waitcnt vmcnt(0)" ::: "memory");
        } else {
            XB_SPIN(xb_ld(&bar[XB_XGEN(b.x)]) == gen, bar);
            __builtin_amdgcn_fence(__ATOMIC_ACQUIRE, "agent");
            asm volatile("s_waitcnt vmcnt(0)" ::: "memory");
        }
    }
    __syncthreads();
}
typedef unsigned short bf16;
typedef float f32x4 __attribute__((ext_vector_type(4)));
typedef unsigned u32x4 __attribute__((ext_vector_type(4)));
typedef float f32x2 __attribute__((ext_vector_type(2)));

constexpr int NWAVES = 8;
constexpr int DM = 2048, SEQ = 2048, NB_P = 4, NB_S = 16, NBATCH = NB_P + NB_S;
constexpr int TOK_P = NB_P * SEQ, TOK = NBATCH * SEQ;
constexpr int NMEM = 256, MEMROWS = NBATCH * NMEM;
constexpr int INC = 4096, DFF = 8192, MEMKV = 1024;
constexpr int C_QA = 0, C_KA = 768, C_VA = 1024, C_QB = 1280, C_KB = 2048, C_VB = 2816, C_QM = 3584;
constexpr float EPS = 1e-6f;

constexpr size_t MiB = 1u << 20;
constexpr size_t WS_ROPE = 1 * MiB;
constexpr size_t WS_WIN = 2 * MiB, WS_WMEM = 18 * MiB;
constexpr size_t WS_WOUT = 22 * MiB, WS_WUP = 30 * MiB, WS_WDOWN = 62 * MiB;
constexpr size_t WS_LSE = 94 * MiB;
constexpr size_t WS_KVM = 96 * MiB;
constexpr size_t WS_H = 112 * MiB, WS_MEMN = 272 * MiB;
constexpr size_t WS_U = 296 * MiB;
constexpr size_t WS_END0 = WS_U + (size_t)TOK * DFF * 2;
constexpr size_t WS_XS = WS_END0;
constexpr size_t XS_BYTES = (size_t)TOK * 8 * 4;
constexpr size_t WS_END = WS_XS + 3 * XS_BYTES;
constexpr int CW_PANEL = 8192, PANEL_BANK = 160 * 64;
constexpr size_t CTL_ZERO_BYTES = (size_t)(CW_PANEL + 3 * PANEL_BANK) * 4;
static_assert(WS_WMEM == WS_WIN + (size_t)INC * DM * 2 && WS_MEMN == WS_H + (size_t)TOK * DM * 2, "contiguous operands");
static_assert(WS_LSE + (size_t)TOK * 6 * 4 <= WS_KVM && WS_KVM + (size_t)MEMROWS * MEMKV * 2 <= WS_H && WS_MEMN + (size_t)MEMROWS * DM * 2 <= WS_U, "ws map");

constexpr int RING_BYTES = 131072;
constexpr int LDS_BYTES = 147456;
static_assert(att::SHM_ATTN <= RING_BYTES && pg8::STAGE_BYTES <= RING_BYTES, "LDS map");

__device__ __forceinline__ float wave_sum(float v) {
#pragma unroll
    for (int o = 1; o < 64; o <<= 1) v += __shfl_xor(v, o);
    return v;
}
__device__ __forceinline__ unsigned f2bf(float f) { unsigned u = __builtin_bit_cast(unsigned, f); return (u + 0x7fffu + ((u >> 16) & 1u)) >> 16; }
__device__ __forceinline__ unsigned pk2(float lo, float hi) { return f2bf(lo) | (f2bf(hi) << 16); }
__device__ __forceinline__ float bflo(unsigned w) { return __uint_as_float(w << 16); }
__device__ __forceinline__ float bfhi(unsigned w) { return __uint_as_float(w & 0xffff0000u); }
__device__ __forceinline__ u32x4 pack8(const f32x4 a, const f32x4 b) { u32x4 o; o.x = pk2(a.x, a.y); o.y = pk2(a.z, a.w); o.z = pk2(b.x, b.y); o.w = pk2(b.z, b.w); return o; }
__device__ __forceinline__ void unpack8(const u32x4 w, f32x4& a, f32x4& b) { a = (f32x4){bflo(w.x), bfhi(w.x), bflo(w.y), bfhi(w.y)}; b = (f32x4){bflo(w.z), bfhi(w.z), bflo(w.w), bfhi(w.w)}; }
__device__ __forceinline__ float sumsq4(const f32x4 a) { return (a.x * a.x + a.y * a.y) + (a.z * a.z + a.w * a.w); }

__device__ __forceinline__ void p0_transpose_item(const float* __restrict__ W, int K, int N, bf16* __restrict__ WT, LAS float* scr, int item, int lane) {
    const int nblk = N / 32, kb = item / nblk, nb = item % nblk, k0 = 64 * kb, n0 = 32 * nb;
#pragma unroll 8
    for (int i = 0; i < 32; ++i) { const int kk = 2 * i + (lane >> 5); scr[kk * 33 + (lane & 31)] = W[(size_t)(k0 + kk) * N + n0 + (lane & 31)]; }
    asm volatile("s_waitcnt lgkmcnt(0)" ::: "memory");
    const int c = lane & 7;
#pragma unroll
    for (int j = 0; j < 4; ++j) { const int n = (lane >> 3) + 8 * j; const LAS float* s = scr + (8 * c) * 33 + n;
        u32x4 o; o.x = pk2(s[0 * 33], s[1 * 33]); o.y = pk2(s[2 * 33], s[3 * 33]); o.z = pk2(s[4 * 33], s[5 * 33]); o.w = pk2(s[6 * 33], s[7 * 33]);
        *(u32x4*)(WT + (size_t)(n0 + n) * K + k0 + 8 * c) = o; }
    asm volatile("s_waitcnt lgkmcnt(0)" ::: "memory");
}

__device__ __forceinline__ void rms_row_to_bf16(const float* __restrict__ src, const float* __restrict__ g, bf16* __restrict__ dst, int lane) {
    f32x4 v[4][2]; float ss = 0.f;
#pragma unroll
    for (int j = 0; j < 4; ++j) { const float* p = src + 8 * (lane + 64 * j); v[j][0] = *(const f32x4*)p; v[j][1] = *(const f32x4*)(p + 4); ss += sumsq4(v[j][0]) + sumsq4(v[j][1]); }
    const float rstd = 1.0f / sqrtf(wave_sum(ss) * (1.0f / DM) + EPS);
#pragma unroll
    for (int j = 0; j < 4; ++j) { const int c = 8 * (lane + 64 * j); const f32x4 g0 = *(const f32x4*)(g + c), g1 = *(const f32x4*)(g + c + 4);
        *(u32x4*)(dst + c) = pack8(v[j][0] * rstd * g0, v[j][1] * rstd * g1); }
}

__device__ __forceinline__ unsigned long long ld_ptr(volatile LAS unsigned long long* PT, int k) { const unsigned long long v = PT[k];
    const unsigned lo = __builtin_amdgcn_readfirstlane((unsigned)v), hi = __builtin_amdgcn_readfirstlane((unsigned)(v >> 32)); return ((unsigned long long)hi << 32) | lo; }
struct Args { const float* in[20]; float* out; unsigned char* ws; int ph_lo, ph_hi; };
constexpr int N_PHASES = 10;

__global__ void __launch_bounds__(NWAVES * 64, 2) mk_fwd(Args args) {
    extern __shared__ __attribute__((aligned(16))) unsigned char lds[];
    cg::grid_group grid = cg::this_grid();
    const int tid = threadIdx.x, lane = tid & 63, wave = __builtin_amdgcn_readfirstlane(tid >> 6);
    const int G = gridDim.x, bid = blockIdx.x;
    const int gw = bid * NWAVES + wave, NGW = G * NWAVES;
    unsigned char* ws = args.ws;
    float* out = args.out;
    f32x2* ROPE = (f32x2*)(ws + WS_ROPE);
    bf16* WIN = (bf16*)(ws + WS_WIN); bf16* WMEM = (bf16*)(ws + WS_WMEM); bf16* WOUT = (bf16*)(ws + WS_WOUT); bf16* WUP = (bf16*)(ws + WS_WUP); bf16* WDOWN = (bf16*)(ws + WS_WDOWN);
    float* LSE = (float*)(ws + WS_LSE); bf16* KVM = (bf16*)(ws + WS_KVM); bf16* H = (bf16*)(ws + WS_H); bf16* U = (bf16*)(ws + WS_U);
    bf16* QKV = U; bf16* Y3 = U; bf16* MIX = H; bf16* H2 = H; bf16* Y5 = H;
    LAS unsigned char* ldsl = (LAS unsigned char*)lds;
    const int lo = args.ph_lo, hi = args.ph_hi;
    volatile LAS unsigned* MISC = (volatile LAS unsigned*)(ldsl + RING_BYTES);
    if (tid < 64) MISC[tid] = 0u;
    volatile LAS unsigned long long* PT = (volatile LAS unsigned long long*)(ldsl + RING_BYTES + 512);
    if (tid == 0) {
        PT[0] = (unsigned long long)args.in[0]; PT[1] = (unsigned long long)args.in[1]; PT[2] = (unsigned long long)args.in[2]; PT[3] = (unsigned long long)args.in[3]; PT[4] = (unsigned long long)args.in[4];
        PT[5] = (unsigned long long)args.in[5]; PT[6] = (unsigned long long)args.in[6]; PT[7] = (unsigned long long)args.in[7]; PT[8] = (unsigned long long)args.in[8]; PT[9] = (unsigned long long)args.in[9];
        PT[10] = (unsigned long long)args.in[10]; PT[11] = (unsigned long long)args.in[11]; PT[12] = (unsigned long long)args.in[12]; PT[13] = (unsigned long long)args.in[13]; PT[14] = (unsigned long long)args.in[14];
        PT[15] = (unsigned long long)args.in[15]; PT[16] = (unsigned long long)args.in[16]; PT[17] = (unsigned long long)args.in[17]; PT[18] = (unsigned long long)args.in[18]; PT[19] = (unsigned long long)args.in[19];
    }
    __syncthreads();
#define INP(k) ((const float*)ld_ptr(PT, (k)))
    XcdBarrier xbar; xbar.bar = (unsigned*)ws; xbar.x = 0; xbar.st = MISC + 8;
    if (hi - lo > 1) xbar = xcd_barrier_post((unsigned*)ws, MISC + 8);
#define IN(k) (lo <= (k) && (k) < hi)
#ifndef REP_SYNC
#define REP_SYNC 1
#endif
#define SEAM(k) do { if (IN(k) && IN((k) + 1)) { for (int s_ = 0; s_ < REP_SYNC; ++s_) { if ((k) == 0) grid.sync(); else xcd_barrier(xbar); } } } while (0)
#define XROW(m) ((m) < TOK_P ? x_p + (size_t)(m) * DM : x_s + (size_t)((m) - TOK_P) * DM)

    if (IN(0)) {
        const float* x_p = INP(0); const float* x_s = INP(1); const float* mem_p = INP(2); const float* mem_s = INP(3); const float* g_premix = INP(5); const float* w_in = INP(6);
        const float* g_mem = INP(9); const float* w_mem = INP(10); const float* w_out = INP(14); const float* w_up = INP(17); const float* w_down = INP(18);
        LAS float* scr = (LAS float*)(ldsl + wave * 16384);
        constexpr int I_IN = (DM / 64) * (INC / 32), I_MEM = (DM / 64) * (MEMKV / 32), I_OUT = (DM / 64) * (DM / 32), I_UP = (DM / 64) * (DFF / 32), I_DN = (DFF / 64) * (DM / 32);
        constexpr int NITEMS = I_IN + I_MEM + I_OUT + I_UP + I_DN;
        for (int it_ = gw; it_ < NITEMS * REP_ROW; it_ += NGW) {
            const int it = it_ % NITEMS; int r = it;
            if (r < I_IN) { p0_transpose_item(w_in, DM, INC, WIN, scr, r, lane); continue; } r -= I_IN;
            if (r < I_MEM) { p0_transpose_item(w_mem, DM, MEMKV, WMEM, scr, r, lane); continue; } r -= I_MEM;
            if (r < I_OUT) { p0_transpose_item(w_out, DM, DM, WOUT, scr, r, lane); continue; } r -= I_OUT;
            if (r < I_UP) { p0_transpose_item(w_up, DM, DFF, WUP, scr, r, lane); continue; } r -= I_UP;
            p0_transpose_item(w_down, DFF, DM, WDOWN, scr, r, lane);
        }
        { const int gt = bid * (NWAVES * 64) + tid; if (gt < 64 * 32) { const int pos = gt >> 5, j = gt & 31; const float inv = powf(10000.0f, -(2.0f * (float)j) / 64.0f); const float ang = (float)pos * inv;
            ROPE[gt] = (f32x2){cosf(ang), sinf(ang)}; } }
        for (int m_ = gw; m_ < (TOK + MEMROWS) * REP_ROW; m_ += NGW) { const int m = m_ % (TOK + MEMROWS);
            const float* src; const float* g = g_premix;
            if (m < TOK) src = XROW(m);
            else { const int mm = m - TOK; g = g_mem; src = mm < NB_P * NMEM ? mem_p + (size_t)mm * DM : mem_s + (size_t)(mm - NB_P * NMEM) * DM; }
            rms_row_to_bf16(src, g, H + (size_t)m * DM, lane);
        }
    }
    SEAM(0);

    if (IN(1)) {
        pg8::Gemm g{H, WIN, TOK, INC, DM}; pg8::StaticOrder S; S.init(TOK, INC, G, bid);
        pg8::EpiOut<0, false> E{QKV, INC, nullptr, 0};
        pg8::gemm_phase<pg8::EpiOut<0, false>, pg8::StaticOrder, true, true>(ldsl, g, S, E);
    }
    SEAM(1);

    if (IN(2)) {
        const float* g_qn = INP(7); const float* g_kn = INP(8);
        const int half = lane >> 5, j = lane & 31;
        const float gq1 = g_qn[64 * half + j], gq2 = g_qn[64 * half + j + 32], gk1 = g_kn[64 * half + j], gk2 = g_kn[64 * half + j + 32];
        for (int t = gw; t < TOK; t += NGW) {
            const int s = t & (SEQ - 1); const int pos = half ? (s & 63) : (s >> 6);
            const f32x2 cs = ROPE[pos * 32 + j];
            bf16* row = QKV + (size_t)t * INC + 64 * half + j;
#pragma unroll
            for (int h8 = 6; h8 < 8; ++h8) {
                const float x1 = bflo((unsigned)row[h8 * 128]), x2 = bflo((unsigned)row[h8 * 128 + 32]);
                const float rstd = 1.0f / sqrtf(wave_sum(x1 * x1 + x2 * x2) * (1.0f / 128.0f) + EPS);
                const float a1 = x1 * rstd * (h8 < 6 ? gq1 : gk1), a2 = x2 * rstd * (h8 < 6 ? gq2 : gk2);
                row[h8 * 128] = (bf16)f2bf(a1 * cs.x - a2 * cs.y); row[h8 * 128 + 32] = (bf16)f2bf(a2 * cs.x + a1 * cs.y);
            }
        }
    }
    SEAM(2);

    if (IN(3)) {
        const float* rel_bias = INP(4); const float* g_qn = INP(7);
        constexpr int NA = NBATCH * 6 * 8, NBU = NBATCH * 6 * 8, NMU = NBATCH * 4 * 8, NMEMU = (MEMROWS / 256) * (MEMKV / 256);
        unsigned* ctl = (unsigned*)ws;
        unsigned* qA = ctl + 4096, * qB = ctl + 4096 + 64, * qM = ctl + 4096 + 128, * kvm_rdy = ctl + 4096 + 192;
        volatile LAS unsigned* qslot = MISC + 16;
        { const int nG = G < NMEMU ? G : NMEMU;
          if (bid >= G - nG) {
            pg8::Gemm g{H, WIN, TOK + MEMROWS, INC + MEMKV, DM}; pg8::ExtraOnly S; S.e0 = bid - (G - nG); S.step = nG; S.n = NMEMU;
            pg8::EpiOut<0, true> E{QKV, INC, KVM, MEMKV};
            pg8::gemm_phase<pg8::EpiOut<0, true>, pg8::ExtraOnly, true, true>(ldsl, g, S, E);
            if (tid == 0) { unsigned mine = 0; for (int e = S.e0; e < NMEMU; e += nG) ++mine;
                __builtin_amdgcn_fence(__ATOMIC_RELEASE, "agent"); asm volatile("s_waitcnt vmcnt(0)" ::: "memory");
                __hip_atomic_fetch_add(kvm_rdy, mine, __ATOMIC_RELAXED, __HIP_MEMORY_SCOPE_AGENT); }
          } }
        const bool deal = (G == 256);
        const int cls = !deal ? 3 : (bid < 176 ? 0 : (bid < 192 ? 1 : 2));
        const int nA_mine = !deal ? (NA - bid + G - 1) / G : (cls == 2 ? 3 : 4);
        const int nS_mine = !deal ? (NBU + NMU - bid + G - 1) / G : (cls == 0 ? 6 : (cls == 1 ? 2 : 8));
#define A_IDX(i) (!deal ? bid + (i) * G : (cls == 0 ? bid + 176 * (i) : ((i) < 3 ? 704 + (bid - 176) + 80 * (i) : 944 + (bid - 176))))
#define S_IDX(i) (!deal ? bid + (i) * G : (cls == 0 ? bid + 176 * (i) : (cls == 1 ? 1056 + (bid - 176) + 16 * (i) : 1088 + (bid - 192) + 64 * (i))))
        for (int i = 0; i < nA_mine * REP_ATTN; ++i) { const int u = A_IDX(i % nA_mine);
            const int qb = u & 7, hq = (u >> 3) % 6, b = u / 48; const size_t r0 = (size_t)b * SEQ;
            att::attn_unit<0, true>(QKV + (r0 + qb * 256) * INC + C_QA + hq * 128, QKV + r0 * INC + C_KA + (hq / 3) * 128, QKV + r0 * INC + C_VA + (hq / 3) * 128,
                              MIX + (r0 + qb * 256) * DM + hq * 128, nullptr, INC, SEQ / 64, 1, 0, 0, 0, nullptr, (char*)lds, g_qn, (const att::f32x2r*)ROPE, qb * 256);
        }
        __syncthreads();
        for (int i = 0; i < nS_mine * REP_ATTN; ++i) { const int v = S_IDX(i % nS_mine); if (v >= NBU) continue;
            const int chunk = v & 7, head = (v >> 3) % 6, b = v / 48, gi = head >> 1; const size_t r0 = (size_t)b * SEQ;
            int dil, two, m0, ms, c, NT;
            if (gi == 0) { dil = 1; two = 0; c = 0; m0 = 256 * chunk; NT = 6; ms = min(max(m0 - 64, 0), SEQ - 384); }
            else if (gi == 1) { dil = 4; two = 0; c = chunk >> 1; m0 = 256 * (chunk & 1); NT = 6; ms = min(max(m0 - 64, 0), SEQ / 4 - 384); }
            else { dil = 16; two = 1; c = 2 * chunk; m0 = 0; ms = 0; NT = 4; }
            const size_t rq = r0 + c + (size_t)m0 * dil, rk = r0 + c;
            att::attn_unit_band(QKV + rq * INC + C_QB + head * 128, QKV + rk * INC + C_KB + head * 128, QKV + rk * INC + C_VB + head * 128,
                                MIX + rq * DM + 768 + head * 128, LSE + rq * 6 + head, INC, NT, dil, two, m0, ms, rel_bias + head, (char*)lds);
        }
        __syncthreads();
        if (tid == 0) { unsigned sp = 0; while (__hip_atomic_load(kvm_rdy, __ATOMIC_RELAXED, __HIP_MEMORY_SCOPE_AGENT) < (unsigned)NMEMU) { __builtin_amdgcn_s_sleep(2); if (++sp > (1u << 22)) break; }
            __builtin_amdgcn_fence(__ATOMIC_ACQUIRE, "agent"); asm volatile("s_waitcnt vmcnt(0)" ::: "memory"); }
        __syncthreads();
#if DYN_M
        { unsigned nxt = 0; if (tid == 0) nxt = __hip_atomic_fetch_add(qM, 1u, __ATOMIC_RELAXED, __HIP_MEMORY_SCOPE_AGENT);
          for (;;) {
            __syncthreads(); if (tid == 0) qslot[0] = nxt; __syncthreads();
            const int vv = __builtin_amdgcn_readfirstlane((int)qslot[0]); if (vv >= NMU * REP_ATTN) break; const int v = vv % NMU;
            if (tid == 0) nxt = __hip_atomic_fetch_add(qM, 1u, __ATOMIC_RELAXED, __HIP_MEMORY_SCOPE_AGENT);
            const int qb = v & 7, hm = (v >> 3) & 3, b = v >> 5; const size_t r0 = (size_t)b * SEQ;
            att::attn_unit<0>(QKV + (r0 + qb * 256) * INC + C_QM + hm * 128, KVM + (size_t)b * NMEM * MEMKV + hm * 128, KVM + (size_t)b * NMEM * MEMKV + 512 + hm * 128,
                              MIX + (r0 + qb * 256) * DM + 1536 + hm * 128, nullptr, MEMKV, NMEM / 64, 1, 0, 0, 0, nullptr, (char*)lds);
          } }
#else
        for (int i = 0; i < nS_mine * REP_ATTN; ++i) { const int v = S_IDX(i % nS_mine) - NBU; if (v < 0) continue;
            const int qb = v & 7, hm = (v >> 3) & 3, b = v >> 5; const size_t r0 = (size_t)b * SEQ;
            att::attn_unit<0>(QKV + (r0 + qb * 256) * INC + C_QM + hm * 128, KVM + (size_t)b * NMEM * MEMKV + hm * 128, KVM + (size_t)b * NMEM * MEMKV + 512 + hm * 128,
                              MIX + (r0 + qb * 256) * DM + 1536 + hm * 128, nullptr, MEMKV, NMEM / 64, 1, 0, 0, 0, nullptr, (char*)lds);
        }
#endif
#undef A_IDX
#undef S_IDX
    }
    SEAM(3);

    if (IN(4)) {
        const float* g_oa = INP(11); const float* g_ob = INP(12); const float* g_om = INP(13);
        for (int t = gw; t < TOK; t += NGW) {
            bf16* row = MIX + (size_t)t * DM; const float* ls = LSE + (size_t)t * 6;
            float al[6];
            { float l[6];
#pragma unroll
              for (int i = 0; i < 6; ++i) l[i] = ls[i];
#pragma unroll
              for (int hp = 0; hp < 2; ++hp) { const float mx = fmaxf(fmaxf(l[hp], l[2 + hp]), l[4 + hp]);
                const float e0 = __expf(l[hp] - mx), e1 = __expf(l[2 + hp] - mx), e2 = __expf(l[4 + hp] - mx), inv = 1.0f / (e0 + e1 + e2);
                al[hp] = e0 * inv; al[2 + hp] = e1 * inv; al[4 + hp] = e2 * inv; } }
            f32x4 v[4][2]; float ssA = 0.f, ssB = 0.f, ssM = 0.f;
#pragma unroll
            for (int j = 0; j < 4; ++j) { const int c = 8 * (lane + 64 * j); unpack8(*(const u32x4*)(row + c), v[j][0], v[j][1]);
                const int seg = c < 768 ? 0 : (c < 1536 ? 1 : 2);
                if (seg == 1) { const int hb = (c - 768) >> 7; float a = al[0];
#pragma unroll
                    for (int i = 1; i < 6; ++i) a = (hb == i) ? al[i] : a;
                    v[j][0] = v[j][0] * a; v[j][1] = v[j][1] * a; }
                const float q = sumsq4(v[j][0]) + sumsq4(v[j][1]);
                ssA += seg == 0 ? q : 0.f; ssB += seg == 1 ? q : 0.f; ssM += seg == 2 ? q : 0.f; }
            const float rA = 1.0f / sqrtf(wave_sum(ssA) * (1.0f / 768.0f) + EPS), rB = 1.0f / sqrtf(wave_sum(ssB) * (1.0f / 768.0f) + EPS), rM = 1.0f / sqrtf(wave_sum(ssM) * (1.0f / 512.0f) + EPS);
#pragma unroll
            for (int j = 0; j < 4; ++j) { const int c = 8 * (lane + 64 * j); const int seg = c < 768 ? 0 : (c < 1536 ? 1 : 2);
                const float* gp = seg == 0 ? g_oa + c : (seg == 1 ? g_ob + (c - 768) : g_om + (c - 1536)); const float r = seg == 0 ? rA : (seg == 1 ? rB : rM);
                const f32x4 g0 = *(const f32x4*)gp, g1 = *(const f32x4*)(gp + 4);
                *(u32x4*)(row + c) = pack8(v[j][0] * r * g0, v[j][1] * r * g1); }
        }
    }
    SEAM(4);

#ifndef DYN_M
#define DYN_M 0
#endif
#ifndef FUSED_LN
#define FUSED_LN 0
#endif
    const bool fusedln = FUSED_LN && (G == 256) && (hi - lo > 1);
    if (IN(5)) {
        if (fusedln) {
            const float* x_p = INP(0); const float* x_s = INP(1); const float* g_postmix = INP(15); const float* g_preffn = INP(16);
            unsigned* ctl = (unsigned*)ws;
            pg8::RowSsq st1{(unsigned*)(ws + WS_XS), ctl + CW_PANEL, 1.0f / DM, EPS}, st2{(unsigned*)(ws + WS_XS + XS_BYTES), ctl + CW_PANEL + PANEL_BANK, 1.0f / DM, EPS};
#pragma nounroll
            for (int r = 0; r < 5; ++r) {
                pg8::Gemm g{MIX, WOUT, TOK, DM, DM}; pg8::PanelRound S{r, bid};
                const float* xb = (r * 32 + (bid & 7) * 4 < TOK_P / 256) ? x_p : x_s - (size_t)TOK_P * DM;
                pg8::EpiRmsResRms E{xb, out, H2, g_postmix, g_preffn, DM, st1, st2};
                pg8::gemm_phase<pg8::EpiRmsResRms, pg8::PanelRound, false, true>(ldsl, g, S, E);
                __syncthreads();
            }
        } else {
        pg8::Gemm g{MIX, WOUT, TOK, DM, DM}; pg8::StaticOrder S; S.init(TOK, DM, G, bid);
        pg8::EpiOut<0, false> E{Y3, DM, nullptr, 0};
        pg8::gemm_phase<pg8::EpiOut<0, false>, pg8::StaticOrder, true, true>(ldsl, g, S, E);
        }
    }
    SEAM(5);

    if (IN(6) && !fusedln) {
        const float* x_p = INP(0); const float* x_s = INP(1); const float* g_postmix = INP(15); const float* g_preffn = INP(16);
        for (int t = gw; t < TOK; t += NGW) {
            const float* xr = XROW(t); const bf16* yr = Y3 + (size_t)t * DM; float* orow = out + (size_t)t * DM;
            f32x4 v[4][2]; float ss = 0.f;
#pragma unroll
            for (int j = 0; j < 4; ++j) { const int c = 8 * (lane + 64 * j); unpack8(*(const u32x4*)(yr + c), v[j][0], v[j][1]); ss += sumsq4(v[j][0]) + sumsq4(v[j][1]); }
            const float r3 = 1.0f / sqrtf(wave_sum(ss) * (1.0f / DM) + EPS); float s1 = 0.f;
#pragma unroll
            for (int j = 0; j < 4; ++j) { const int c = 8 * (lane + 64 * j);
                const f32x4 g0 = *(const f32x4*)(g_postmix + c), g1 = *(const f32x4*)(g_postmix + c + 4), x0 = *(const f32x4*)(xr + c), x1 = *(const f32x4*)(xr + c + 4);
                v[j][0] = x0 + v[j][0] * r3 * g0; v[j][1] = x1 + v[j][1] * r3 * g1;
                *(f32x4*)(orow + c) = v[j][0]; *(f32x4*)(orow + c + 4) = v[j][1]; s1 += sumsq4(v[j][0]) + sumsq4(v[j][1]); }
            const float r1 = 1.0f / sqrtf(wave_sum(s1) * (1.0f / DM) + EPS);
#pragma unroll
            for (int j = 0; j < 4; ++j) { const int c = 8 * (lane + 64 * j); const f32x4 g0 = *(const f32x4*)(g_preffn + c), g1 = *(const f32x4*)(g_preffn + c + 4);
                *(u32x4*)(H2 + (size_t)t * DM + c) = pack8(v[j][0] * r1 * g0, v[j][1] * r1 * g1); }
        }
    }
    if (!fusedln) SEAM(6);

    if (IN(7)) {
        pg8::Gemm g{H2, WUP, TOK, DFF, DM}; pg8::StaticOrder S; S.init(TOK, DFF, G, bid);
        pg8::EpiOut<2, false> E{U, DFF, nullptr, 0};
        pg8::gemm_phase<pg8::EpiOut<2, false>, pg8::StaticOrder, true, true>(ldsl, g, S, E);
    }
    SEAM(7);

    if (IN(8)) {
        if (fusedln) {
            const float* g_postffn = INP(19);
            unsigned* ctl = (unsigned*)ws;
            pg8::RowSsq st{(unsigned*)(ws + WS_XS + 2 * XS_BYTES), ctl + CW_PANEL + 2 * PANEL_BANK, 1.0f / DM, EPS};
#pragma nounroll
            for (int r = 0; r < 5; ++r) {
                pg8::Gemm g{U, WDOWN, TOK, DM, DFF}; pg8::PanelRound S{r, bid};
                pg8::EpiRmsRes E{out, g_postffn, DM, st};
                pg8::gemm_phase<pg8::EpiRmsRes, pg8::PanelRound, false, true>(ldsl, g, S, E);
                __syncthreads();
            }
        } else {
        pg8::Gemm g{U, WDOWN, TOK, DM, DFF}; pg8::StaticOrder S; S.init(TOK, DM, G, bid);
        pg8::EpiOut<0, false> E{Y5, DM, nullptr, 0};
        pg8::gemm_phase<pg8::EpiOut<0, false>, pg8::StaticOrder, true, true>(ldsl, g, S, E);
        }
    }
    if (!fusedln) SEAM(8);

    if (IN(9) && !fusedln) {
        const float* g_postffn = INP(19);
        for (int t = gw; t < TOK; t += NGW) {
            const bf16* yr = Y5 + (size_t)t * DM; float* orow = out + (size_t)t * DM;
            f32x4 v[4][2]; float ss = 0.f;
#pragma unroll
            for (int j = 0; j < 4; ++j) { const int c = 8 * (lane + 64 * j); unpack8(*(const u32x4*)(yr + c), v[j][0], v[j][1]); ss += sumsq4(v[j][0]) + sumsq4(v[j][1]); }
            const float r5 = 1.0f / sqrtf(wave_sum(ss) * (1.0f / DM) + EPS);
#pragma unroll
            for (int j = 0; j < 4; ++j) { const int c = 8 * (lane + 64 * j);
                const f32x4 g0 = *(const f32x4*)(g_postffn + c), g1 = *(const f32x4*)(g_postffn + c + 4), x0 = *(const f32x4*)(orow + c), x1 = *(const f32x4*)(orow + c + 4);
                *(f32x4*)(orow + c) = x0 + v[j][0] * r5 * g0; *(f32x4*)(orow + c + 4) = x1 + v[j][1] * r5 * g1; }
        }
    }
#undef IN
#undef SEAM
#undef XROW
}

#ifndef MK_N_LAUNCHES
#define MK_N_LAUNCHES 1
#endif
extern "C" void kernel_launch(void* const* d_in, const int* in_sizes, int n_in, void* d_out, int out_size, void* d_ws, size_t ws_size, hipStream_t stream) {
    static int grid = 0;
    if (grid == 0) {
        if (n_in != 20 || in_sizes[0] != TOK_P * DM || in_sizes[1] != (TOK - TOK_P) * DM || out_size != TOK * DM || ws_size < WS_END) {
            fprintf(stderr, "kernel_launch: shape mismatch: n_in %d in0 %d in1 %d out %d ws %zu (need %zu); nothing launched\n", n_in, n_in > 0 ? in_sizes[0] : -1, n_in > 1 ? in_sizes[1] : -1, out_size, ws_size, (size_t)WS_END);
            grid = -1; return; }
        int dev = 0, cus = 0, per_cu = 0;
        if (hipGetDevice(&dev) != hipSuccess || hipDeviceGetAttribute(&cus, hipDeviceAttributeMultiprocessorCount, dev) != hipSuccess) { fprintf(stderr, "kernel_launch: device query failed\n"); grid = -1; return; }
        if (hipFuncSetAttribute((const void*)mk_fwd, hipFuncAttributeMaxDynamicSharedMemorySize, LDS_BYTES) != hipSuccess) { fprintf(stderr, "kernel_launch: hipFuncSetAttribute failed\n"); grid = -1; return; }
        if (hipOccupancyMaxActiveBlocksPerMultiprocessor(&per_cu, (const void*)mk_fwd, NWAVES * 64, LDS_BYTES) != hipSuccess || per_cu < 1) { fprintf(stderr, "kernel_launch: occupancy query says %d\n", per_cu); per_cu = 1; }
        (void)hipGetLastError();
        grid = cus * per_cu;
    }
    if (grid < 0) return;
    if (hipMemsetAsync(d_ws, 0, CTL_ZERO_BYTES, stream) != hipSuccess) { fprintf(stderr, "kernel_launch: memset failed\n"); return; }
    Args a{};
    for (int i = 0; i < 20; ++i) a.in[i] = (const float*)d_in[i];
    a.out = (float*)d_out; a.ws = (unsigned char*)d_ws;
#if MK_N_LAUNCHES == 1
    a.ph_lo = 0; a.ph_hi = N_PHASES;
    void* kargs[] = {&a};
    const hipError_t e = hipLaunchCooperativeKernel((const void*)mk_fwd, dim3(grid), dim3(NWAVES * 64), kargs, LDS_BYTES, stream);
    if (e != hipSuccess) fprintf(stderr, "kernel_launch: cooperative launch failed: %s (grid %d)\n", hipGetErrorString(e), grid);
#else
    for (int p = 0; p < N_PHASES; ++p) { a.ph_lo = p; a.ph_hi = p + 1; hipLaunchKernelGGL(mk_fwd, dim3(grid), dim3(NWAVES * 64), LDS_BYTES, stream, a); }
#endif
}
```
